# Optimizing an MI355X kernel written in HIP

```python
import math
import jax, jax.numpy as jnp
from jax import lax
import numpy as np

D_MODEL = 1024
BATCH = 8
SEQ = 4096
DEPTH = 1

GRID_W = 64
CTX_LEN = 256
N_HEADS = 8
QK_NOPE_DIM = 64
QK_ROPE_DIM = 32
V_HEAD_DIM = 64
Q_LORA_RANK = 256
KV_LORA_RANK = 128
MLA_WIDTH = N_HEADS * V_HEAD_DIM
CONV_WIDTH = D_MODEL - MLA_WIDTH
CONV_K = 3
D_FF = 4 * D_MODEL
ROPE_THETA = 10000.0
ROPE_AXIS_DIM = QK_ROPE_DIM // 2
Q_BLOCK = 128
EPS = 1e-6
MLA_IN = Q_LORA_RANK + KV_LORA_RANK + QK_ROPE_DIM
IN_COLS = MLA_IN + 3 * CONV_WIDTH
QK_DIM = QK_NOPE_DIM + QK_ROPE_DIM
ATTN_SCALE = 1.0 / math.sqrt(QK_DIM)

kernel_name = 'hybrid_mla_shortconv_dit_layer'


def rmsnorm(x):
    xf = x.astype(jnp.float32)
    y = xf * lax.rsqrt(jnp.mean(xf * xf, axis=-1, keepdims=True) + EPS)
    return y.astype(x.dtype)


def modulate(x, shift, scale):
    return rmsnorm(x) * (1 + scale) + shift


def adaln(cvec, w_mod, b_mod):
    m = jax.nn.silu(cvec) @ w_mod + b_mod
    return jnp.split(m, 6, axis=-1)


def rope_tables(rows):
    row = jnp.broadcast_to(jnp.arange(rows)[:, None], (rows, GRID_W)).reshape(-1)
    col = jnp.broadcast_to(jnp.arange(GRID_W)[None, :], (rows, GRID_W)).reshape(-1)
    freqs = ROPE_THETA ** (-jnp.arange(0, ROPE_AXIS_DIM, 2, dtype=jnp.float32) / ROPE_AXIS_DIM)
    ang = jnp.stack([row.astype(jnp.float32)[:, None] * freqs,
                     col.astype(jnp.float32)[:, None] * freqs], axis=1)
    ang = ang[:, None]
    return jnp.cos(ang), jnp.sin(ang)


def apply_rope(x, cos, sin):
    xs = x.reshape(x.shape[:-1] + (2, 2, ROPE_AXIS_DIM // 2))
    x1, x2 = xs[..., 0, :], xs[..., 1, :]
    cos = cos.astype(x.dtype)
    sin = sin.astype(x.dtype)
    out = jnp.stack([x1 * cos - x2 * sin, x2 * cos + x1 * sin], axis=-2)
    return out.reshape(x.shape)


def mla_q(z, q_g, w_uq, cos, sin):
    cq = rmsnorm(z[..., :Q_LORA_RANK]) * q_g
    q = (cq @ w_uq).reshape(z.shape[:-1] + (N_HEADS, QK_DIM))
    q_nope, q_rope = q[..., :QK_NOPE_DIM], q[..., QK_NOPE_DIM:]
    if cos is not None:
        q_rope = apply_rope(q_rope, cos, sin)
    return jnp.concatenate([q_nope, q_rope], axis=-1)


def mla_kv(z, kv_g, w_ukv, cos, sin):
    ckv = rmsnorm(z[..., Q_LORA_RANK:Q_LORA_RANK + KV_LORA_RANK]) * kv_g
    k_rope = z[..., Q_LORA_RANK + KV_LORA_RANK:MLA_IN][..., None, :]
    kv = (ckv @ w_ukv).reshape(z.shape[:-1] + (N_HEADS, QK_NOPE_DIM + V_HEAD_DIM))
    k_nope, v = kv[..., :QK_NOPE_DIM], kv[..., QK_NOPE_DIM:]
    if cos is not None:
        k_rope = apply_rope(k_rope, cos, sin)
    k_rope = jnp.broadcast_to(k_rope, k_nope.shape[:-1] + (QK_ROPE_DIM,))
    return jnp.concatenate([k_nope, k_rope], axis=-1), v


def attention_dense(q, k, v):
    s = jnp.einsum('bqhd,bkhd->bhqk', q, k).astype(jnp.float32) * ATTN_SCALE
    p = jax.nn.softmax(s, axis=-1).astype(v.dtype)
    o = jnp.einsum('bhqk,bkhd->bqhd', p, v)
    return o.reshape(o.shape[:2] + (N_HEADS * V_HEAD_DIM,))


def attention_blocked(q, k, v):
    b, s = q.shape[0], q.shape[1]
    nblk = s // Q_BLOCK
    qb = q.reshape(b, nblk, Q_BLOCK, N_HEADS, QK_DIM).swapaxes(0, 1)
    o = lax.map(lambda qq: attention_dense(qq, k, v), qb)
    return o.swapaxes(0, 1).reshape(b, s, N_HEADS * V_HEAD_DIM)


def short_conv(z, conv_w):
    gb, gc, xin = jnp.split(z[..., MLA_IN:], 3, axis=-1)
    u = gc * xin
    n = u.shape[1]
    up = jnp.pad(u, ((0, 0), (1, 1), (0, 0)))
    y = conv_w[0] * up[:, :n] + conv_w[1] * up[:, 1:n + 1] + conv_w[2] * up[:, 2:n + 2]
    return gb * y


def sq_relu_mlp(h, w1, w2):
    return jnp.square(jax.nn.relu(h @ w1)) @ w2


def setup_inputs(seed: int = 0) -> dict:
    key = jax.random.key(seed)
    ks = jax.random.split(key, 16)
    f32 = jnp.float32
    n = lambda k, shape, s: jax.random.normal(k, shape, f32) * s
    return {
        'x': n(ks[0], (BATCH, SEQ, D_MODEL), 1.0),
        'c': n(ks[1], (BATCH, D_MODEL), 1.0),
        'ctx': n(ks[2], (BATCH, CTX_LEN, D_MODEL), 1.0),
        'c_ctx': n(ks[3], (D_MODEL,), 1.0),
        'w_mod': n(ks[4], (DEPTH, D_MODEL, 6 * D_MODEL), D_MODEL ** -0.5),
        'b_mod': n(ks[5], (DEPTH, 6 * D_MODEL), 0.02),
        'w_in': n(ks[6], (DEPTH, D_MODEL, IN_COLS), D_MODEL ** -0.5),
        'q_norm_g': 1.0 + n(ks[7], (DEPTH, Q_LORA_RANK), 0.1),
        'w_uq': n(ks[8], (DEPTH, Q_LORA_RANK, N_HEADS * QK_DIM), Q_LORA_RANK ** -0.5),
        'kv_norm_g': 1.0 + n(ks[9], (DEPTH, KV_LORA_RANK), 0.1),
        'w_ukv': n(ks[10], (DEPTH, KV_LORA_RANK, N_HEADS * (QK_NOPE_DIM + V_HEAD_DIM)), KV_LORA_RANK ** -0.5),
        'conv_w': n(ks[11], (DEPTH, CONV_K, CONV_WIDTH), CONV_K ** -0.5),
        'w_out': n(ks[12], (DEPTH, D_MODEL, D_MODEL), D_MODEL ** -0.5),
        'w_mlp1': n(ks[13], (DEPTH, D_MODEL, D_FF), D_MODEL ** -0.5),
        'w_mlp2': n(ks[14], (DEPTH, D_FF, D_MODEL), D_FF ** -0.5),
        'final_norm_g': 1.0 + n(ks[15], (D_MODEL,), 0.1),
    }


def reference(x, c, ctx, c_ctx, w_mod, b_mod, w_in, q_norm_g, w_uq, kv_norm_g, w_ukv,
              conv_w, w_out, w_mlp1, w_mlp2, final_norm_g):
    rows = x.shape[1] // GRID_W
    cos, sin = rope_tables(rows)
    ctx_s = ctx
    for i in range(DEPTH):
        sh1, sc1, g1, sh2, sc2, g2 = [m[:, None, :] for m in adaln(c, w_mod[i], b_mod[i])]
        sh1c, sc1c, g1c, sh2c, sc2c, g2c = adaln(c_ctx, w_mod[i], b_mod[i])

        z = modulate(x, sh1, sc1) @ w_in[i]
        zc = modulate(ctx_s, sh1c, sc1c) @ w_in[i]

        q = mla_q(z, q_norm_g[i], w_uq[i], cos, sin)
        k, v = mla_kv(z, kv_norm_g[i], w_ukv[i], cos, sin)
        kc, vc = mla_kv(zc, kv_norm_g[i], w_ukv[i], None, None)
        k_all = jnp.concatenate([k, kc], axis=1)
        v_all = jnp.concatenate([v, vc], axis=1)
        attn = attention_blocked(q, k_all, v_all)
        conv = short_conv(z, conv_w[i])
        x = x + g1 * (jnp.concatenate([attn, conv], axis=-1) @ w_out[i])

        x = x + g2 * sq_relu_mlp(modulate(x, sh2, sc2), w_mlp1[i], w_mlp2[i])

        if i + 1 < DEPTH:
            qc = mla_q(zc, q_norm_g[i], w_uq[i], None, None)
            attn_c = attention_dense(qc, kc, vc)
            conv_c = short_conv(zc, conv_w[i])
            ctx_s = ctx_s + g1c * (jnp.concatenate([attn_c, conv_c], axis=-1) @ w_out[i])
            ctx_s = ctx_s + g2c * sq_relu_mlp(modulate(ctx_s, sh2c, sc2c), w_mlp1[i], w_mlp2[i])

    return rmsnorm(x) * final_norm_g
```

```cpp
#include <hip/hip_runtime.h>
#include <hip/hip_cooperative_groups.h>
#include <cstdio>
#include <cstdint>
namespace cg = cooperative_groups;
namespace pg8 {
#define PG8_LAS __attribute__((address_space(3)))
typedef unsigned short bf16_t;
typedef short bf16x8 __attribute__((ext_vector_type(8)));
typedef float f32x4 __attribute__((ext_vector_type(4)));
typedef unsigned u32x4 __attribute__((ext_vector_type(4)));
constexpr int BM = 256, BK = 64, HALF = 128, HTB = HALF * BK * 2  , STAGE_BYTES = 8 * HTB, NXCD = 8, WGM = 8;

__host__ __device__ __forceinline__ int lds_byte(int r, int c) { const int st = (r >> 4) * 2 + (c >> 5), rr = r & 15, cc = c & 31, ob = rr * 64 + cc * 2; return st * 1024 + (ob ^ (((ob >> 9) & 1) << 5)); }
__host__ __device__ __forceinline__ void stage_rc(int b, int& R, int& C) { const int st = b / 1024, sb = b % 1024, swz = sb ^ (((sb >> 9) & 1) << 5); R = (st >> 1) * 16 + swz / 64; C = (st & 1) * 32 + (swz % 64) / 2; }
__host__ __device__ __forceinline__ int perm32(int rho) { const int n = rho >> 4, i = rho & 15; return 8 * (i >> 2) + 4 * n + (i & 3); }

struct Unit { int pm, pn; };
struct Gemm { const bf16_t* A; const bf16_t* Bt; int M, N, K; };
__device__ __forceinline__ unsigned cvt_pk_bf16(float lo, float hi) { unsigned r; asm volatile("v_cvt_pk_bf16_f32 %0, %1, %2" : "=v"(r) : "v"(lo), "v"(hi)); return r; }
typedef float f32x2 __attribute__((ext_vector_type(2)));
template <class Epi, class Sched, bool ALIGN_EPI = false, bool SP2 = false>
__device__ __forceinline__ void gemm_phase(PG8_LAS unsigned char* lds, const Gemm g, const Sched& S, const Epi& E) {
    int tid_ = threadIdx.x; asm volatile("" : "+v"(tid_));
    const int tid = tid_, wid = __builtin_amdgcn_readfirstlane(tid >> 6), lane = tid & 63, wr = wid >> 2, wc = wid & 3, fr = lane & 15, fq = lane >> 4;
    const int K = g.K, nt = K / BK;
    unsigned voffA[2], voffB[2];
#pragma unroll
    for (int i = 0; i < 2; ++i) { int R, C; stage_rc(tid * 16 + i * 8192, R, C); const int Rb = Epi::PERM ? ((R & ~31) + perm32(R & 31)) : R;
        voffA[i] = (unsigned)(R * K + C) * 2u; voffB[i] = (unsigned)(Rb * K + C) * 2u; }
    const size_t kstep = (size_t)(BK * 2);
    const size_t hstep = (size_t)HALF * K * 2;
    const size_t tstep = 2 * hstep;
    const unsigned ldsw = (unsigned)wid * 1024u;
    const int aoff = lds_byte(wr * 64 + fr, fq * 8), boff = lds_byte(wc * 32 + fr, fq * 8);
#define PG8_SA(b, h) (((b) * 2 + (h)) * HTB)
#define PG8_SB(b, h) ((4 + (b) * 2 + (h)) * HTB)
#define PG8_STAGE(bufoff, gbase, voff) do { _Pragma("unroll") for (int _i = 0; _i < 2; ++_i) \
        __builtin_amdgcn_global_load_lds((const unsigned*)((const char*)(gbase) + (voff)[_i]), (PG8_LAS unsigned*)(lds + (bufoff) + ldsw + _i * 8192), 16, 0, 0); } while (0)
#define PG8_LDA(dst, b, h) do { _Pragma("unroll") for (int m = 0; m < 4; ++m) _Pragma("unroll") for (int k = 0; k < 2; ++k) dst[m][k] = *(const PG8_LAS bf16x8*)(lds + PG8_SA(b, h) + aoff + m * 2048 + k * 1024); } while (0)
#define PG8_LDB(dst, b, h) do { _Pragma("unroll") for (int n = 0; n < 2; ++n) _Pragma("unroll") for (int k = 0; k < 2; ++k) dst[n][k] = *(const PG8_LAS bf16x8*)(lds + PG8_SB(b, h) + boff + n * 2048 + k * 1024); } while (0)
#define PG8_MMA(ai, bj, At, Bt) do { __builtin_amdgcn_s_setprio(1); _Pragma("unroll") for (int m = 0; m < 4; ++m) _Pragma("unroll") for (int n = 0; n < 2; ++n) _Pragma("unroll") for (int k = 0; k < 2; ++k) \
        acc[ai][bj][m][n] = __builtin_amdgcn_mfma_f32_16x16x32_bf16(Bt[n][k], At[m][k], acc[ai][bj][m][n], 0, 0, 0); __builtin_amdgcn_s_setprio(0); } while (0)
#define PG8_WAIT_V(n) asm volatile("s_waitcnt vmcnt(" #n ")" ::: "memory")
#define PG8_WAIT_L(n) asm volatile("s_waitcnt lgkmcnt(" #n ")" ::: "memory")
#define PG8_BAR __builtin_amdgcn_s_barrier()
#define PG8_SCHED __builtin_amdgcn_sched_barrier(0)
    Unit cur, nxt; int ui = 0;
    if (!S.next(0, cur)) return;
    f32x4 acc[2][2][4][2];
#pragma unroll
    for (int a = 0; a < 2; ++a)
#pragma unroll
        for (int b = 0; b < 2; ++b)
#pragma unroll
            for (int m = 0; m < 4; ++m)
#pragma unroll
                for (int n = 0; n < 2; ++n) acc[a][b][m][n] = (f32x4){0.f, 0.f, 0.f, 0.f};
    bf16x8 At[4][2], B0[2][2], B1[2][2];
    const char* cA = (const char*)g.A + (size_t)cur.pm * tstep; const char* cB = (const char*)g.Bt + (size_t)cur.pn * tstep;
    S.a_ready(cur);
    if constexpr (SP2) {
        PG8_STAGE(PG8_SB(0, 0), cB, voffB); PG8_STAGE(PG8_SB(0, 1), cB + hstep, voffB); PG8_STAGE(PG8_SA(0, 0), cA, voffA); PG8_STAGE(PG8_SA(0, 1), cA + hstep, voffA);
        if (wr == 1) PG8_BAR;
        PG8_WAIT_V(2); PG8_BAR;
        PG8_STAGE(PG8_SB(1, 0), cB + kstep, voffB); PG8_STAGE(PG8_SA(1, 0), cA + kstep, voffA); PG8_STAGE(PG8_SB(1, 1), cB + hstep + kstep, voffB);
        PG8_WAIT_V(6); PG8_BAR;
    } else {
        PG8_STAGE(PG8_SB(0, 0), cB, voffB); PG8_STAGE(PG8_SA(0, 0), cA, voffA); PG8_STAGE(PG8_SB(0, 1), cB + hstep, voffB); PG8_STAGE(PG8_SA(0, 1), cA + hstep, voffA);
        if (wr == 1) PG8_BAR;
        PG8_WAIT_V(4); PG8_BAR;
        PG8_STAGE(PG8_SB(1, 0), cB + kstep, voffB); PG8_STAGE(PG8_SA(1, 0), cA + kstep, voffA); PG8_STAGE(PG8_SB(1, 1), cB + hstep + kstep, voffB);
        PG8_WAIT_V(6); PG8_BAR;
    }
    for (;;) {
        const bool has_next = S.next(ui + 1, nxt);
        const char* nA = has_next ? (const char*)g.A + (size_t)nxt.pm * tstep : cA; const char* nB = has_next ? (const char*)g.Bt + (size_t)nxt.pn * tstep : cB;
#pragma clang loop unroll(disable)
        for (int t = 0; t < nt; t += 2) {
            const bool last = (t == nt - 2);
            const char* a1 = cA + (size_t)(t + 1) * kstep;
            const char* a2 = last ? nA : cA + (size_t)(t + 2) * kstep; const char* b2 = last ? nB : cB + (size_t)(t + 2) * kstep;
            const char* a3 = a2 + kstep; const char* b3 = b2 + kstep;
            if (last && has_next) S.a_ready(nxt);
            if constexpr (SP2) {
            PG8_LDB(B0, 0, 0); PG8_LDB(B1, 0, 1); PG8_SCHED; PG8_LDA(At, 0, 0); PG8_STAGE(PG8_SA(1, 1), a1 + hstep, voffA);
            PG8_WAIT_V(8); PG8_WAIT_L(0); PG8_BAR; PG8_MMA(0, 0, At, B0); PG8_MMA(0, 1, At, B1); PG8_BAR; PG8_SCHED;
            PG8_LDA(At, 0, 1); PG8_STAGE(PG8_SB(0, 0), b2, voffB); PG8_STAGE(PG8_SB(0, 1), b2 + hstep, voffB); PG8_STAGE(PG8_SA(0, 0), a2, voffA);
            PG8_WAIT_V(8); PG8_WAIT_L(0); PG8_BAR; PG8_MMA(1, 0, At, B0); PG8_MMA(1, 1, At, B1); PG8_BAR; PG8_SCHED;
            PG8_LDB(B0, 1, 0); PG8_LDB(B1, 1, 1); PG8_SCHED; PG8_LDA(At, 1, 0); PG8_STAGE(PG8_SA(0, 1), a2 + hstep, voffA);
            PG8_WAIT_V(8); PG8_WAIT_L(0); PG8_BAR; PG8_MMA(0, 0, At, B0); PG8_MMA(0, 1, At, B1); PG8_BAR; PG8_SCHED;
            PG8_LDA(At, 1, 1); PG8_STAGE(PG8_SB(1, 0), b3, voffB); PG8_STAGE(PG8_SB(1, 1), b3 + hstep, voffB); PG8_STAGE(PG8_SA(1, 0), a3, voffA);
            PG8_WAIT_V(8); PG8_WAIT_L(0); PG8_BAR; PG8_MMA(1, 0, At, B0); PG8_MMA(1, 1, At, B1); PG8_BAR; PG8_SCHED;
            } else {
            PG8_LDB(B0, 0, 0); PG8_SCHED; PG8_LDA(At, 0, 0); PG8_STAGE(PG8_SA(1, 1), a1 + hstep, voffA);
            PG8_WAIT_L(8); PG8_BAR; PG8_WAIT_L(0); PG8_MMA(0, 0, At, B0); PG8_BAR; PG8_SCHED;
            PG8_LDB(B1, 0, 1); PG8_STAGE(PG8_SB(0, 0), b2, voffB);
            PG8_BAR; PG8_WAIT_L(0); PG8_MMA(0, 1, At, B1); PG8_BAR;
            PG8_LDA(At, 0, 1); PG8_STAGE(PG8_SA(0, 0), a2, voffA);
            PG8_BAR; PG8_WAIT_L(0); PG8_MMA(1, 0, At, B0); PG8_BAR; PG8_SCHED;
            PG8_STAGE(PG8_SB(0, 1), b2 + hstep, voffB);
            PG8_WAIT_V(6); PG8_BAR; PG8_MMA(1, 1, At, B1); PG8_BAR;
            PG8_LDB(B0, 1, 0); PG8_SCHED; PG8_LDA(At, 1, 0); PG8_STAGE(PG8_SA(0, 1), a2 + hstep, voffA);
            PG8_WAIT_L(8); PG8_BAR; PG8_WAIT_L(0); PG8_MMA(0, 0, At, B0); PG8_BAR; PG8_SCHED;
            PG8_LDB(B1, 1, 1); PG8_STAGE(PG8_SB(1, 0), b3, voffB);
            PG8_BAR; PG8_WAIT_L(0); PG8_MMA(0, 1, At, B1); PG8_BAR;
            PG8_LDA(At, 1, 1); PG8_STAGE(PG8_SA(1, 0), a3, voffA);
            PG8_BAR; PG8_WAIT_L(0); PG8_MMA(1, 0, At, B0); PG8_BAR; PG8_SCHED;
            PG8_STAGE(PG8_SB(1, 1), b3 + hstep, voffB);
            PG8_WAIT_V(6); PG8_BAR; PG8_MMA(1, 1, At, B1); PG8_BAR;
            }
        }
        if constexpr (ALIGN_EPI) { if (wr == 0) PG8_BAR; }
        if constexpr (!Epi::AFTER_DRAIN) { E(acc, cur, wr, wc, fr, fq); S.done(cur); }
        if (!has_next) break;
#pragma unroll
        for (int a = 0; a < 2; ++a)
#pragma unroll
            for (int b = 0; b < 2; ++b)
#pragma unroll
                for (int m = 0; m < 4; ++m)
#pragma unroll
                    for (int n = 0; n < 2; ++n) acc[a][b][m][n] = (f32x4){0.f, 0.f, 0.f, 0.f};
        cur = nxt; cA = nA; cB = nB; ++ui;
        if constexpr (ALIGN_EPI) { if (wr == 1) PG8_BAR; }
    }
    PG8_WAIT_V(0);
    if constexpr (!ALIGN_EPI) { if (wr == 0) PG8_BAR; }
    PG8_BAR;
    if constexpr (Epi::AFTER_DRAIN) { E.fused(acc, cur, wr, wc, fr, fq, lds, wid, lane); S.done(cur); }
#undef PG8_SA
#undef PG8_SB
#undef PG8_STAGE
#undef PG8_LDA
#undef PG8_LDB
#undef PG8_MMA
#undef PG8_WAIT_V
#undef PG8_WAIT_L
#undef PG8_BAR
#undef PG8_SCHED
}
}

constexpr int DM = 1024, NB = 8, SEQ = 4096, CTX = 256, TOK = SEQ + CTX  , MROWS = NB * TOK  ;
constexpr int NHEAD = 8, DQK = 96, DV = 64, QLR = 256, KVLR = 128, INC = 1952, ZP = 2048  , ZW = 1536  , DFF = 4096, NMOD = 6 * DM;
constexpr float EPS = 1e-6f;
typedef pg8::bf16_t bf16_t;
typedef pg8::f32x4 f32x4;
typedef pg8::u32x4 u32x4;
typedef pg8::bf16x8 bf16x8;
typedef unsigned u32x2 __attribute__((ext_vector_type(2)));
#define LAS __attribute__((address_space(3)))

constexpr size_t MiB = 1u << 20;
constexpr size_t WS_MOD = 0, WS_TAB = 512 * 1024, WS_BAR = 768 * 1024, WS_SSQ = 256 * 1024  , WS_B2 = 5 * MiB + 768 * 1024  ;
constexpr size_t WS_WIN = 1 * MiB, WS_WUQ = 5 * MiB, WS_WKV = 5 * MiB + 512 * 1024, WS_WO = 6 * MiB, WS_W1 = 8 * MiB, WS_W2 = 16 * MiB;
constexpr size_t WS_XN = 24 * MiB, WS_AC = 92 * MiB, WS_V = 160 * MiB, WS_R = 194 * MiB;
constexpr size_t WS_Z = WS_R, WS_CQ = WS_R + 136 * MiB, WS_CKV = WS_R + 153 * MiB, WS_Q = WS_R + 162 * MiB, WS_K = WS_R + 213 * MiB, WS_H = WS_R;
constexpr size_t WS_KV = WS_R + 213 * MiB  , WS_KR = WS_V  , WS_SSQ2 = WS_V + 4 * MiB  ;
constexpr size_t WS_END = WS_R + 282 * MiB;

__device__ __forceinline__ float bf2f(unsigned short h) { return __uint_as_float(((unsigned)h) << 16); }
__device__ __forceinline__ float bflo(unsigned w) { return __uint_as_float(w << 16); }
__device__ __forceinline__ float bfhi(unsigned w) { return __uint_as_float(w & 0xffff0000u); }
__device__ __forceinline__ unsigned pk2(float lo, float hi) { return pg8::cvt_pk_bf16(lo, hi); }
#define DPP_ADD(v, CTRL) ((v) + __builtin_bit_cast(float, __builtin_amdgcn_update_dpp(0, __builtin_bit_cast(int, (v)), (CTRL), 0xf, 0xf, true)))
__device__ __forceinline__ void st16_wt(void* p, u32x4 v) { asm volatile("global_store_dwordx4 %0, %1, off sc1\n\ts_nop 2" :: "v"(p), "v"(v) : "memory"); }
__device__ __forceinline__ float wave_sum(float v) {
    v = DPP_ADD(v, 0xB1);
    v = DPP_ADD(v, 0x4E);
    v = DPP_ADD(v, 0x141);
    v = DPP_ADD(v, 0x140);
    const int iv = __builtin_bit_cast(int, v);
    const float r0 = __builtin_bit_cast(float, __builtin_amdgcn_readlane(iv, 0)), r1 = __builtin_bit_cast(float, __builtin_amdgcn_readlane(iv, 16));
    const float r2 = __builtin_bit_cast(float, __builtin_amdgcn_readlane(iv, 32)), r3 = __builtin_bit_cast(float, __builtin_amdgcn_readlane(iv, 48));
    return (r0 + r1) + (r2 + r3);
}

struct Sched {
    int nN, nU, nUlat, G, v, latmap;
    __device__ __forceinline__ bool next(int i, pg8::Unit& u) const {
        const int U = i * G + v; if (U >= nU) return false;
        if (U < nUlat) { const int l = U / nN; u.pn = U - l * nN; u.pm = latmap ? l + (l >> 4) : l; }
        else { const int b = U - nUlat; u.pm = b * 17 + 16; u.pn = 1; }
        return true;
    }
    __device__ __forceinline__ void a_ready(const pg8::Unit&) const {}
    __device__ __forceinline__ void done(const pg8::Unit&) const {}
};

struct SchedUp {
    int v;
    __device__ __forceinline__ bool next(int i, pg8::Unit& u) const {
        if (i >= 8) return false;
        const int x = v >> 5, s = v & 31; const int l = 16 * x + 8 * (i >> 2) + (s & 7); u.pn = 4 * (i & 3) + (s >> 3); u.pm = l + (l >> 4); return true;
    }
    __device__ __forceinline__ void a_ready(const pg8::Unit&) const {}
    __device__ __forceinline__ void done(const pg8::Unit&) const {}
};
struct SchedRow {
    int pm, n;
    __device__ __forceinline__ bool next(int i, pg8::Unit& u) const { if (i >= n) return false; u.pm = pm; u.pn = i; return true; }
    __device__ __forceinline__ void a_ready(const pg8::Unit&) const {}
    __device__ __forceinline__ void done(const pg8::Unit&) const {}
};
struct SchedOne {
    int pm, pn;
    __device__ __forceinline__ bool next(int i, pg8::Unit& u) const { if (i) return false; u.pm = pm; u.pn = pn; return true; }
    __device__ __forceinline__ void a_ready(const pg8::Unit&) const {}
    __device__ __forceinline__ void done(const pg8::Unit&) const {}
};
template <int ACT  > struct EpiStore {
    static constexpr bool PERM = true, AFTER_DRAIN = false;
    bf16_t* O; int ldc; float sc;
    __device__ __forceinline__ void operator()(const f32x4 (&acc)[2][2][4][2], const pg8::Unit& u, int wr, int wc, int fr_, int fq_) const {
        int fr = fr_, fq = fq_; asm volatile("" : "+v"(fr), "+v"(fq));
        const int row0 = u.pm * 256 + wr * 64 + fr, col0 = u.pn * 256 + wc * 32 + 8 * fq;
#pragma unroll
        for (int ai = 0; ai < 2; ++ai)
#pragma unroll
            for (int m = 0; m < 4; ++m) { bf16_t* rowp = O + (size_t)(row0 + ai * 128 + m * 16) * ldc + col0;
#pragma unroll
                for (int bj = 0; bj < 2; ++bj) { f32x4 v0 = acc[ai][bj][m][0], v1 = acc[ai][bj][m][1];
                    if (ACT == 1) {
#pragma unroll
                        for (int j = 0; j < 4; ++j) { float a = fmaxf(v0[j], 0.f), b = fmaxf(v1[j], 0.f); v0[j] = a * a; v1[j] = b * b; } }
                    if (ACT == 2) { v0 = v0 * sc; v1 = v1 * sc; }
                    u32x4 w; w.x = pk2(v0[0], v0[1]); w.y = pk2(v0[2], v0[3]); w.z = pk2(v1[0], v1[1]); w.w = pk2(v1[2], v1[3]);
                    *(u32x4*)(rowp + bj * 128) = w; } }
    }
};
struct EpiRes2 {
    static constexpr bool PERM = true, AFTER_DRAIN = false;
    const bf16_t* x1b; bf16_t* x2b; const float* gate; unsigned long long* ssq;
    __device__ __forceinline__ void operator()(const f32x4 (&acc)[2][2][4][2], const pg8::Unit& u, int wr, int wc, int fr_, int fq_) const {
        int fr = fr_, fq = fq_; asm volatile("" : "+v"(fr), "+v"(fq));
        const int b = u.pm / 17; const int orow0 = (u.pm - b) * 256 + wr * 64 + fr;
        float ss[2][4];
#pragma unroll
        for (int ai = 0; ai < 2; ++ai)
#pragma unroll
            for (int m = 0; m < 4; ++m) ss[ai][m] = 0.f;
#pragma unroll
        for (int bj = 0; bj < 2; ++bj) {
            const int col0 = u.pn * 256 + bj * 128 + wc * 32 + 8 * fq;
            const f32x4 g0 = *(const f32x4*)(gate + b * NMOD + col0), g1 = *(const f32x4*)(gate + b * NMOD + col0 + 4);
            u32x4 xr[2][4];
#pragma unroll
            for (int ai = 0; ai < 2; ++ai)
#pragma unroll
                for (int m = 0; m < 4; ++m) xr[ai][m] = __builtin_nontemporal_load((const u32x4*)(x1b + (size_t)(orow0 + ai * 128 + m * 16) * DM + col0));
#pragma unroll
            for (int ai = 0; ai < 2; ++ai)
#pragma unroll
                for (int m = 0; m < 4; ++m) { const size_t off = (size_t)(orow0 + ai * 128 + m * 16) * DM + col0;
                    const u32x4 xw = xr[ai][m];
                    const f32x4 x0 = {bflo(xw.x), bfhi(xw.x), bflo(xw.y), bfhi(xw.y)}, x1 = {bflo(xw.z), bfhi(xw.z), bflo(xw.w), bfhi(xw.w)};
                    const f32x4 y0 = x0 + g0 * acc[ai][bj][m][0], y1 = x1 + g1 * acc[ai][bj][m][1];
                    ss[ai][m] += ((y0[0] * y0[0] + y0[1] * y0[1]) + (y0[2] * y0[2] + y0[3] * y0[3])) + ((y1[0] * y1[0] + y1[1] * y1[1]) + (y1[2] * y1[2] + y1[3] * y1[3]));
                    u32x4 w; w.x = pk2(y0[0], y0[1]); w.y = pk2(y0[2], y0[3]); w.z = pk2(y1[0], y1[1]); w.w = pk2(y1[2], y1[3]);
                    *(u32x4*)(x2b + off) = w; } }
#pragma unroll
        for (int ai = 0; ai < 2; ++ai)
#pragma unroll
            for (int m = 0; m < 4; ++m) { float v = ss[ai][m]; v += __shfl_xor(v, 16); v += __shfl_xor(v, 32);
                if (fq == 0) __hip_atomic_fetch_add(ssq + orow0 + ai * 128 + m * 16, (unsigned long long)(v * 16777216.f), __ATOMIC_RELAXED, __HIP_MEMORY_SCOPE_AGENT); }
    }
};
struct EpiZ {
    static constexpr bool PERM = true, AFTER_DRAIN = false;
    bf16_t* O;
    __device__ __forceinline__ void operator()(const f32x4 (&acc)[2][2][4][2], const pg8::Unit& u, int wr, int wc, int fr_, int fq_) const {
        int fr = fr_, fq = fq_; asm volatile("" : "+v"(fr), "+v"(fq));
        const int row0 = u.pm * 256 + wr * 64 + fr;
        if (u.pn < 4) {
#pragma unroll
            for (int bj = 0; bj < 2; ++bj) { const int col0 = u.pn * 256 + bj * 128 + wc * 32 + 8 * fq;
                if (col0 < 928) {
#pragma unroll
                    for (int ai = 0; ai < 2; ++ai)
#pragma unroll
                        for (int m = 0; m < 4; ++m) { const f32x4 v0 = acc[ai][bj][m][0], v1 = acc[ai][bj][m][1];
                            u32x4 w; w.x = pk2(v0[0], v0[1]); w.y = pk2(v0[2], v0[3]); w.z = pk2(v1[0], v1[1]); w.w = pk2(v1[2], v1[3]);
                            *(u32x4*)(O + (size_t)(row0 + ai * 128 + m * 16) * ZW + col0) = w; } } }
        } else {
            const int col0 = 928 + (u.pn - 4) * 128 + wc * 32 + 8 * fq;
#pragma unroll
            for (int ai = 0; ai < 2; ++ai)
#pragma unroll
                for (int m = 0; m < 4; ++m) { const f32x4 v0 = acc[ai][0][m][0] * acc[ai][1][m][0], v1 = acc[ai][0][m][1] * acc[ai][1][m][1];
                    u32x4 w; w.x = pk2(v0[0], v0[1]); w.y = pk2(v0[2], v0[3]); w.z = pk2(v1[0], v1[1]); w.w = pk2(v1[2], v1[3]);
                    *(u32x4*)(O + (size_t)(row0 + ai * 128 + m * 16) * ZW + col0) = w; }
        }
    }
};
struct EpiRes1 {
    static constexpr bool PERM = true, AFTER_DRAIN = false;
    const float* x; bf16_t* x1b; const float* mod; bf16_t* xn; unsigned long long* ssq;
    __device__ __forceinline__ void operator()(const f32x4 (&acc)[2][2][4][2], const pg8::Unit& u, int wr, int wc, int fr_, int fq_) const {
        int fr = fr_, fq = fq_; asm volatile("" : "+v"(fr), "+v"(fq));
        const int b = u.pm / 17; const int orow0 = (u.pm - b) * 256 + wr * 64 + fr, crow0 = u.pm * 256 + wr * 64 + fr;
        float ss[2][4];
#pragma unroll
        for (int ai = 0; ai < 2; ++ai)
#pragma unroll
            for (int m = 0; m < 4; ++m) ss[ai][m] = 0.f;
#pragma unroll
        for (int bj = 0; bj < 2; ++bj) {
            const int col0 = u.pn * 256 + bj * 128 + wc * 32 + 8 * fq; const float* mb = mod + b * NMOD + col0;
            const f32x4 g0 = *(const f32x4*)(mb + 2 * DM), g1 = *(const f32x4*)(mb + 2 * DM + 4); const f32x4 s0 = *(const f32x4*)(mb + 4 * DM) + 1.f, s1 = *(const f32x4*)(mb + 4 * DM + 4) + 1.f;
#pragma unroll
            for (int ai = 0; ai < 2; ++ai) {
                f32x4 xr0[4], xr1[4];
#pragma unroll
                for (int m = 0; m < 4; ++m) { const size_t off = (size_t)(orow0 + ai * 128 + m * 16) * DM + col0;
                    xr0[m] = __builtin_nontemporal_load((const f32x4*)(x + off)); xr1[m] = __builtin_nontemporal_load((const f32x4*)(x + off + 4)); }
#pragma unroll
                for (int m = 0; m < 4; ++m) { const int ro = ai * 128 + m * 16; const size_t off = (size_t)(orow0 + ro) * DM + col0;
                    const f32x4 x0 = xr0[m], x1 = xr1[m];
                    const f32x4 y0 = x0 + g0 * acc[ai][bj][m][0], y1 = x1 + g1 * acc[ai][bj][m][1];
                    { u32x4 w1; w1.x = pk2(y0[0], y0[1]); w1.y = pk2(y0[2], y0[3]); w1.z = pk2(y1[0], y1[1]); w1.w = pk2(y1[2], y1[3]); *(u32x4*)(x1b + off) = w1; }
                    ss[ai][m] += ((y0[0] * y0[0] + y0[1] * y0[1]) + (y0[2] * y0[2] + y0[3] * y0[3])) + ((y1[0] * y1[0] + y1[1] * y1[1]) + (y1[2] * y1[2] + y1[3] * y1[3]));
                    const f32x4 a0 = y0 * s0, a1 = y1 * s1;
                    u32x4 w; w.x = pk2(a0[0], a0[1]); w.y = pk2(a0[2], a0[3]); w.z = pk2(a1[0], a1[1]); w.w = pk2(a1[2], a1[3]);
                    *(u32x4*)(xn + (size_t)(crow0 + ro) * DM + col0) = w; } } }
#pragma unroll
        for (int ai = 0; ai < 2; ++ai)
#pragma unroll
            for (int m = 0; m < 4; ++m) { float v = ss[ai][m]; v += __shfl_xor(v, 16); v += __shfl_xor(v, 32);
                if (fq == 0) __hip_atomic_fetch_add(ssq + orow0 + ai * 128 + m * 16, (unsigned long long)(v * 16777216.f), __ATOMIC_RELAXED, __HIP_MEMORY_SCOPE_AGENT); }
    }
};
struct EpiMlp1 {
    static constexpr bool PERM = true, AFTER_DRAIN = false;
    bf16_t* O; const unsigned long long* ssq; const float* bias2;
    __device__ __forceinline__ void operator()(const f32x4 (&acc)[2][2][4][2], const pg8::Unit& u, int wr, int wc, int fr_, int fq_) const {
        int fr = fr_, fq = fq_; asm volatile("" : "+v"(fr), "+v"(fq));
        const int b = u.pm / 17; const int orow0 = (u.pm - b) * 256 + wr * 64 + fr, crow0 = u.pm * 256 + wr * 64 + fr;
        float rs[2][4];
#pragma unroll
        for (int ai = 0; ai < 2; ++ai)
#pragma unroll
            for (int m = 0; m < 4; ++m) rs[ai][m] = rsqrtf((float)ssq[orow0 + ai * 128 + m * 16] * (1.f / (16777216.f * DM)) + EPS);
#pragma unroll
        for (int bj = 0; bj < 2; ++bj) {
            const int col0 = u.pn * 256 + bj * 128 + wc * 32 + 8 * fq;
            const f32x4 b0 = *(const f32x4*)(bias2 + b * DFF + col0), b1 = *(const f32x4*)(bias2 + b * DFF + col0 + 4);
#pragma unroll
            for (int ai = 0; ai < 2; ++ai)
#pragma unroll
                for (int m = 0; m < 4; ++m) { f32x4 v0 = acc[ai][bj][m][0] * rs[ai][m] + b0, v1 = acc[ai][bj][m][1] * rs[ai][m] + b1;
#pragma unroll
                    for (int j = 0; j < 4; ++j) { const float p = fmaxf(v0[j], 0.f), q = fmaxf(v1[j], 0.f); v0[j] = p * p; v1[j] = q * q; }
                    u32x4 w; w.x = pk2(v0[0], v0[1]); w.y = pk2(v0[2], v0[3]); w.z = pk2(v1[0], v1[1]); w.w = pk2(v1[2], v1[3]);
                    *(u32x4*)(O + (size_t)(crow0 + ai * 128 + m * 16) * DFF + col0) = w; } }
    }
};

struct EpiMlp1L {
    static constexpr bool PERM = true, AFTER_DRAIN = false;
    bf16_t* O; const LAS float* rsT; const LAS float* bsT;
    __device__ __forceinline__ void operator()(const f32x4 (&acc)[2][2][4][2], const pg8::Unit& u, int wr, int wc, int fr_, int fq_) const {
        int fr = fr_, fq = fq_; asm volatile("" : "+v"(fr), "+v"(fq));
        const int b = u.pm / 17; const int l = u.pm - b; const int crow0 = u.pm * 256 + wr * 64 + fr;
        const LAS float* rp = rsT + ((l >> 3) & 1) * 256 + wr * 64 + fr; const LAS float* bp = bsT + (u.pn >> 2) * 256 + wc * 32 + 8 * fq;
        float rs[2][4];
#pragma unroll
        for (int ai = 0; ai < 2; ++ai)
#pragma unroll
            for (int m = 0; m < 4; ++m) rs[ai][m] = rp[ai * 128 + m * 16];
#pragma unroll
        for (int bj = 0; bj < 2; ++bj) {
            const int col0 = u.pn * 256 + bj * 128 + wc * 32 + 8 * fq;
            const f32x4 b0 = *(const LAS f32x4*)(bp + bj * 128), b1 = *(const LAS f32x4*)(bp + bj * 128 + 4);
#pragma unroll
            for (int ai = 0; ai < 2; ++ai)
#pragma unroll
                for (int m = 0; m < 4; ++m) { f32x4 v0 = acc[ai][bj][m][0] * rs[ai][m] + b0, v1 = acc[ai][bj][m][1] * rs[ai][m] + b1;
#pragma unroll
                    for (int j = 0; j < 4; ++j) { const float p = fmaxf(v0[j], 0.f), q = fmaxf(v1[j], 0.f); v0[j] = p * p; v1[j] = q * q; }
                    u32x4 w; w.x = pk2(v0[0], v0[1]); w.y = pk2(v0[2], v0[3]); w.z = pk2(v1[0], v1[1]); w.w = pk2(v1[2], v1[3]);
                    *(u32x4*)(O + (size_t)(crow0 + ai * 128 + m * 16) * DFF + col0) = w; } }
    }
};

struct EpiRes1L {
    static constexpr bool PERM = true, AFTER_DRAIN = false;
    const float* x; bf16_t* x1b; const LAS float* gT; const LAS float* sT; bf16_t* xn; unsigned long long* ssq;
    __device__ __forceinline__ void operator()(const f32x4 (&acc)[2][2][4][2], const pg8::Unit& u, int wr, int wc, int fr_, int fq_) const {
        int fr = fr_, fq = fq_; asm volatile("" : "+v"(fr), "+v"(fq));
        const int b = u.pm / 17; const int orow0 = (u.pm - b) * 256 + wr * 64 + fr, crow0 = u.pm * 256 + wr * 64 + fr;
        float ss[2][4];
#pragma unroll
        for (int ai = 0; ai < 2; ++ai)
#pragma unroll
            for (int m = 0; m < 4; ++m) ss[ai][m] = 0.f;
#pragma unroll
        for (int bj = 0; bj < 2; ++bj) {
            const int col0 = u.pn * 256 + bj * 128 + wc * 32 + 8 * fq; const int ti = (((u.pm - b) >> 6) & 1) * 256 + bj * 128 + wc * 32 + 8 * fq;
            const f32x4 g0 = *(const LAS f32x4*)(gT + ti), g1 = *(const LAS f32x4*)(gT + ti + 4); const f32x4 s0 = *(const LAS f32x4*)(sT + ti), s1 = *(const LAS f32x4*)(sT + ti + 4);
#pragma unroll
            for (int ai = 0; ai < 2; ++ai) {
                f32x4 xr0[4], xr1[4];
#pragma unroll
                for (int m = 0; m < 4; ++m) { const size_t off = (size_t)(orow0 + ai * 128 + m * 16) * DM + col0;
                    xr0[m] = __builtin_nontemporal_load((const f32x4*)(x + off)); xr1[m] = __builtin_nontemporal_load((const f32x4*)(x + off + 4)); }
#pragma unroll
                for (int m = 0; m < 4; ++m) { const int ro = ai * 128 + m * 16; const size_t off = (size_t)(orow0 + ro) * DM + col0;
                    const f32x4 x0 = xr0[m], x1 = xr1[m];
                    const f32x4 y0 = x0 + g0 * acc[ai][bj][m][0], y1 = x1 + g1 * acc[ai][bj][m][1];
                    { u32x4 w1; w1.x = pk2(y0[0], y0[1]); w1.y = pk2(y0[2], y0[3]); w1.z = pk2(y1[0], y1[1]); w1.w = pk2(y1[2], y1[3]); *(u32x4*)(x1b + off) = w1; }
                    ss[ai][m] += ((y0[0] * y0[0] + y0[1] * y0[1]) + (y0[2] * y0[2] + y0[3] * y0[3])) + ((y1[0] * y1[0] + y1[1] * y1[1]) + (y1[2] * y1[2] + y1[3] * y1[3]));
                    const f32x4 a0 = y0 * s0, a1 = y1 * s1;
                    u32x4 w; w.x = pk2(a0[0], a0[1]); w.y = pk2(a0[2], a0[3]); w.z = pk2(a1[0], a1[1]); w.w = pk2(a1[2], a1[3]);
                    *(u32x4*)(xn + (size_t)(crow0 + ro) * DM + col0) = w; } } }
#pragma unroll
        for (int ai = 0; ai < 2; ++ai)
#pragma unroll
            for (int m = 0; m < 4; ++m) { float v = ss[ai][m]; v += __shfl_xor(v, 16); v += __shfl_xor(v, 32);
                if (fq == 0) __hip_atomic_fetch_add(ssq + orow0 + ai * 128 + m * 16, (unsigned long long)(v * 16777216.f), __ATOMIC_RELAXED, __HIP_MEMORY_SCOPE_AGENT); }
    }
};

struct EpiRes2L {
    static constexpr bool PERM = true, AFTER_DRAIN = false;
    const bf16_t* x1b; bf16_t* x2b; const LAS float* gT; unsigned long long* ssq;
    __device__ __forceinline__ void operator()(const f32x4 (&acc)[2][2][4][2], const pg8::Unit& u, int wr, int wc, int fr_, int fq_) const {
        int fr = fr_, fq = fq_; asm volatile("" : "+v"(fr), "+v"(fq));
        const int b = u.pm / 17; const int orow0 = (u.pm - b) * 256 + wr * 64 + fr;
        float ss[2][4];
#pragma unroll
        for (int ai = 0; ai < 2; ++ai)
#pragma unroll
            for (int m = 0; m < 4; ++m) ss[ai][m] = 0.f;
#pragma unroll
        for (int bj = 0; bj < 2; ++bj) {
            const int col0 = u.pn * 256 + bj * 128 + wc * 32 + 8 * fq;
            const int ti = (((u.pm - b) >> 6) & 1) * 256 + bj * 128 + wc * 32 + 8 * fq; const f32x4 g0 = *(const LAS f32x4*)(gT + ti), g1 = *(const LAS f32x4*)(gT + ti + 4);
            u32x4 xr[2][4];
#pragma unroll
            for (int ai = 0; ai < 2; ++ai)
#pragma unroll
                for (int m = 0; m < 4; ++m) xr[ai][m] = __builtin_nontemporal_load((const u32x4*)(x1b + (size_t)(orow0 + ai * 128 + m * 16) * DM + col0));
#pragma unroll
            for (int ai = 0; ai < 2; ++ai)
#pragma unroll
                for (int m = 0; m < 4; ++m) { const size_t off = (size_t)(orow0 + ai * 128 + m * 16) * DM + col0;
                    const u32x4 xw = xr[ai][m];
                    const f32x4 x0 = {bflo(xw.x), bfhi(xw.x), bflo(xw.y), bfhi(xw.y)}, x1 = {bflo(xw.z), bfhi(xw.z), bflo(xw.w), bfhi(xw.w)};
                    const f32x4 y0 = x0 + g0 * acc[ai][bj][m][0], y1 = x1 + g1 * acc[ai][bj][m][1];
                    ss[ai][m] += ((y0[0] * y0[0] + y0[1] * y0[1]) + (y0[2] * y0[2] + y0[3] * y0[3])) + ((y1[0] * y1[0] + y1[1] * y1[1]) + (y1[2] * y1[2] + y1[3] * y1[3]));
                    u32x4 w; w.x = pk2(y0[0], y0[1]); w.y = pk2(y0[2], y0[3]); w.z = pk2(y1[0], y1[1]); w.w = pk2(y1[2], y1[3]);
                    st16_wt(x2b + off, w); } }
#pragma unroll
        for (int ai = 0; ai < 2; ++ai)
#pragma unroll
            for (int m = 0; m < 4; ++m) { float v = ss[ai][m]; v += __shfl_xor(v, 16); v += __shfl_xor(v, 32);
                if (fq == 0) __hip_atomic_fetch_add(ssq + orow0 + ai * 128 + m * 16, (unsigned long long)(v * 16777216.f), __ATOMIC_RELAXED, __HIP_MEMORY_SCOPE_AGENT); }
    }
};

namespace att {
using s16x4 = __attribute__((ext_vector_type(4))) short;
using f32x16 = __attribute__((ext_vector_type(16))) float;
constexpr int NW = 8, QBLK = 32, KVBLK = 64, LDQ = 768, LDK = 1024  , LDKR = 32  , LDV = 1024, LDO = 1024;
constexpr float SCALE = 0.10206207261596575f;
constexpr float THRL = 8.f;
constexpr float C2 = SCALE * 1.4426950408889634f;
constexpr int SHM_K = 12 * 1024, SHM_V = 64 * 64 * 2;
constexpr int OFF_V = 0, OFF_K = 3 * SHM_V, OFF_WS = OFF_K + 3 * SHM_K, OFF_OST = OFF_WS + NW * 64 * 4, ATT_LDS = OFF_OST + NW * 4096;
#define KSWZ(row, colB) ((row) * 256 + ((colB) ^ (((row) & 7) << 4)))
#define SBAR() __builtin_amdgcn_sched_barrier(0)
__device__ __forceinline__ int crow(int r, int hi) { return (r & 3) + 8 * (r >> 2) + 4 * hi; }
__device__ __forceinline__ unsigned cvtpk(float lo, float hi) { unsigned r; asm volatile("v_cvt_pk_bf16_f32 %0, %1, %2" : "=v"(r) : "v"(lo), "v"(hi)); return r; }
__device__ __forceinline__ float rowmax32(const f32x16& p0, const f32x16& p1) {
  float pmax = p0[0];
#pragma unroll
  for (int r = 1; r < 16; ++r) pmax = fmaxf(pmax, p0[r]);
#pragma unroll
  for (int r = 0; r < 16; ++r) pmax = fmaxf(pmax, p1[r]);
  auto rr = __builtin_amdgcn_permlane32_swap(__float_as_uint(pmax), __float_as_uint(pmax), false, false);
  return fmaxf(__uint_as_float(rr[0]), __uint_as_float(rr[1]));
}
__device__ __forceinline__ void move_ref(f32x16& p0, f32x16& p1, float dl, float& m_hat, f32x16& negm) {
  m_hat += dl;
#pragma unroll
  for (int r = 0; r < 16; ++r) { p0[r] -= dl; p1[r] -= dl; }
#pragma unroll
  for (int r = 0; r < 16; ++r) negm[r] = -m_hat;
}
__device__ __forceinline__ void exp16(f32x16& p) {
#pragma unroll
  for (int r = 0; r < 16; ++r) p[r] = __builtin_amdgcn_exp2f(p[r]);
}
__device__ __forceinline__ void finishSM(f32x16& p0, f32x16& p1, float alpha, float& l_reg, bf16x8& pa0, bf16x8& pa1, bf16x8& pa2, bf16x8& pa3) {
#pragma unroll
  for (int r = 0; r < 16; ++r) p1[r] = __builtin_amdgcn_exp2f(p1[r]);
  float ps = 0;
#pragma unroll
  for (int r = 0; r < 16; ++r) ps += p0[r];
#pragma unroll
  for (int r = 0; r < 16; ++r) ps += p1[r];
  { auto rr = __builtin_amdgcn_permlane32_swap(__float_as_uint(ps), __float_as_uint(ps), false, false);
    ps = __uint_as_float(rr[0]) + __uint_as_float(rr[1]); }
  l_reg = l_reg * alpha + ps;
#define PK4(P, BASE, OUT) do { u32x4 w = {cvtpk(P[BASE + 0], P[BASE + 1]), cvtpk(P[BASE + 2], P[BASE + 3]), cvtpk(P[BASE + 4], P[BASE + 5]), cvtpk(P[BASE + 6], P[BASE + 7])}; \
    OUT = *reinterpret_cast<bf16x8*>(&w); } while (0)
  PK4(p0, 0, pa0); PK4(p0, 8, pa1); PK4(p1, 0, pa2); PK4(p1, 8, pa3);
#undef PK4
}
__device__ __forceinline__ void kload(bf16x8* kf, const char* Ks, int r32, int hi) {
  const char* kb = Ks + hi * 1024 + r32 * 16;
#pragma unroll
  for (int d0 = 0; d0 < 6; ++d0) { kf[2 * d0] = *reinterpret_cast<const bf16x8*>(kb + d0 * 2048); kf[2 * d0 + 1] = *reinterpret_cast<const bf16x8*>(kb + d0 * 2048 + 512); }
}
__device__ __forceinline__ void qkt(f32x16& p0, f32x16& p1, const bf16x8* kf, const bf16x8* qr, const f32x16& negm) {
  p0 = negm; p1 = negm;
#pragma unroll
  for (int d0 = 0; d0 < 6; ++d0) {
    p0 = __builtin_amdgcn_mfma_f32_32x32x16_bf16(kf[2 * d0], qr[d0], p0, 0, 0, 0);
    p1 = __builtin_amdgcn_mfma_f32_32x32x16_bf16(kf[2 * d0 + 1], qr[d0], p1, 0, 0, 0); }
}
__device__ __forceinline__ int v_st(int k, int c) { const int kk = k; return ((kk >> 3) * 2 + (c >> 5)) * 512 + ((kk & 7) * 32 + (c & 31)) * 2; }
__device__ __forceinline__ int v_rd_base(int lane) { return ((lane & 3) << 3) | (((lane >> 2) & 3) << 6) | (((lane >> 4) & 1) << 5) | (((lane >> 5) & 1) << 8); }
constexpr int v_rd_off(int d0, int ks, int half) { return d0 * 512 + ks * 2048 + half * 1024; }
template <int OFF> __device__ __forceinline__ s16x4 tr_read(int vb) {
  s16x4 r; asm volatile("ds_read_b64_tr_b16 %0, %1 offset:%2" : "=&v"(r) : "v"(vb), "i"(OFF) : "memory"); return r;
}
typedef __attribute__((address_space(3))) const char* lds_cptr;
typedef short v4i16_t __attribute__((ext_vector_type(4)));
__device__ __forceinline__ s16x4 vtr(lds_cptr p) { return __builtin_bit_cast(s16x4, __builtin_amdgcn_ds_read_tr16_b64_v4i16((__attribute__((address_space(3))) v4i16_t*)p)); }
__device__ __forceinline__ void pv_softmax(f32x16* o, lds_cptr vp, bf16x8 pa0, bf16x8 pa1, bf16x8 pa2, bf16x8 pa3, f32x16& c0, f32x16& c1, float& m_hat, f32x16& negm, float& alpha) {
  s16x4 vl[8], vh[8];
#pragma unroll
  for (int d0 = 0; d0 < 2; ++d0)
#pragma unroll
    for (int ks = 0; ks < 4; ++ks) { vl[d0 * 4 + ks] = vtr(vp + v_rd_off(d0, ks, 0)); vh[d0 * 4 + ks] = vtr(vp + v_rd_off(d0, ks, 1)); }
  const float rm = rowmax32(c0, c1);
#define PKV(i) (bf16x8){vl[i][0], vl[i][1], vl[i][2], vl[i][3], vh[i][0], vh[i][1], vh[i][2], vh[i][3]}
  o[0] = __builtin_amdgcn_mfma_f32_32x32x16_bf16(pa0, PKV(0), o[0], 0, 0, 0);
  o[1] = __builtin_amdgcn_mfma_f32_32x32x16_bf16(pa0, PKV(4), o[1], 0, 0, 0);
  o[0] = __builtin_amdgcn_mfma_f32_32x32x16_bf16(pa1, PKV(1), o[0], 0, 0, 0);
  o[1] = __builtin_amdgcn_mfma_f32_32x32x16_bf16(pa1, PKV(5), o[1], 0, 0, 0);
  o[0] = __builtin_amdgcn_mfma_f32_32x32x16_bf16(pa2, PKV(2), o[0], 0, 0, 0);
  o[1] = __builtin_amdgcn_mfma_f32_32x32x16_bf16(pa2, PKV(6), o[1], 0, 0, 0);
  o[0] = __builtin_amdgcn_mfma_f32_32x32x16_bf16(pa3, PKV(3), o[0], 0, 0, 0);
  o[1] = __builtin_amdgcn_mfma_f32_32x32x16_bf16(pa3, PKV(7), o[1], 0, 0, 0);
#undef PKV
  alpha = 1.f;
  if (__builtin_expect(__any(rm > THRL), 0)) { const float dl = fmaxf(rm, 0.f); move_ref(c0, c1, dl, m_hat, negm); alpha = __builtin_amdgcn_exp2f(-dl); }
  exp16(c0);
  asm volatile("" : "+v"(c0));
}
__device__ __forceinline__ void pv_only(f32x16* o, lds_cptr vp, bf16x8 pa0, bf16x8 pa1, bf16x8 pa2, bf16x8 pa3) {
#pragma unroll
  for (int d0 = 0; d0 < 2; ++d0) { s16x4 l[4], h[4];
#pragma unroll
    for (int ks = 0; ks < 4; ++ks) { l[ks] = vtr(vp + v_rd_off(d0, ks, 0)); h[ks] = vtr(vp + v_rd_off(d0, ks, 1)); }
#define PKV(i) (bf16x8){l[i][0], l[i][1], l[i][2], l[i][3], h[i][0], h[i][1], h[i][2], h[i][3]}
    o[d0] = __builtin_amdgcn_mfma_f32_32x32x16_bf16(pa0, PKV(0), o[d0], 0, 0, 0); o[d0] = __builtin_amdgcn_mfma_f32_32x32x16_bf16(pa1, PKV(1), o[d0], 0, 0, 0);
    o[d0] = __builtin_amdgcn_mfma_f32_32x32x16_bf16(pa2, PKV(2), o[d0], 0, 0, 0); o[d0] = __builtin_amdgcn_mfma_f32_32x32x16_bf16(pa3, PKV(3), o[d0], 0, 0, 0);
#undef PKV
  }
}
template <int D0> __device__ __forceinline__ void pv_one(f32x16& od, int vb, bf16x8 pa0, bf16x8 pa1, bf16x8 pa2, bf16x8 pa3) {
  const s16x4 l0 = tr_read<v_rd_off(D0, 0, 0)>(vb), h0 = tr_read<v_rd_off(D0, 0, 1)>(vb), l1 = tr_read<v_rd_off(D0, 1, 0)>(vb), h1 = tr_read<v_rd_off(D0, 1, 1)>(vb);
  const s16x4 l2 = tr_read<v_rd_off(D0, 2, 0)>(vb), h2 = tr_read<v_rd_off(D0, 2, 1)>(vb), l3 = tr_read<v_rd_off(D0, 3, 0)>(vb), h3 = tr_read<v_rd_off(D0, 3, 1)>(vb);
  asm volatile("s_waitcnt lgkmcnt(0)" ::: "memory"); SBAR();
#define PK(L, H) (bf16x8){L[0], L[1], L[2], L[3], H[0], H[1], H[2], H[3]}
  od = __builtin_amdgcn_mfma_f32_32x32x16_bf16(pa0, PK(l0, h0), od, 0, 0, 0);
  od = __builtin_amdgcn_mfma_f32_32x32x16_bf16(pa1, PK(l1, h1), od, 0, 0, 0);
  od = __builtin_amdgcn_mfma_f32_32x32x16_bf16(pa2, PK(l2, h2), od, 0, 0, 0);
  od = __builtin_amdgcn_mfma_f32_32x32x16_bf16(pa3, PK(l3, h3), od, 0, 0, 0);
#undef PK
}
__device__ __forceinline__ void pv_d0(f32x16* o, int vb, bf16x8 pa0, bf16x8 pa1, bf16x8 pa2, bf16x8 pa3) {
  pv_one<0>(o[0], vb, pa0, pa1, pa2, pa3); pv_one<1>(o[1], vb, pa0, pa1, pa2, pa3);
}
struct AttnRegs { bf16x8 qr[6]; struct { bf16x8 ks0, ks1, vs0; } sr_[2]; bf16x8 k2a, k2b; };
__device__ __forceinline__ void attn_unit(const bf16_t* __restrict__ Qb, const bf16_t* __restrict__ Kh, const bf16_t* __restrict__ Krp, const bf16_t* __restrict__ Vh, bf16_t* __restrict__ Ob, int seq, char* lds, const float* __restrict__ tab, int t0,
                                          AttnRegs& R, bool pre, bool has_next, const bf16_t* __restrict__ Qn, const bf16_t* __restrict__ Khn, const bf16_t* __restrict__ Krn, const bf16_t* __restrict__ Vhn) {
  int tid_ = threadIdx.x; asm volatile("" : "+v"(tid_));
  const int tid = tid_, wid = tid >> 6, lane = tid & 63, r32 = lane & 31, hi = lane >> 5;
  char* V_lds = lds + OFF_V; char* K_lds = lds + OFF_K;
  float* ws = (float*)(lds + OFF_WS) + wid * 64; float* li_l = ws; float* al_l = ws + 32;
  float m_hat = 0.f, l_reg = 0; f32x16 o[2] = {}; bf16x8 (&qr)[6] = R.qr; f32x16 negm = f32x16{};
  if (!pre) { const long qoff = (long)(wid * QBLK + r32) * LDQ + hi * 8;
#pragma unroll
    for (int d0 = 0; d0 < 6; ++d0) qr[d0] = *reinterpret_cast<const bf16x8*>(Qb + qoff + d0 * 16); }
  { const int t = t0 + wid * QBLK + r32;
#pragma unroll
    for (int ax = 0; ax < 2; ++ax) { const int pos = ax == 0 ? (t >> 6) : (t & 63); const float* tp = tab + (pos * 8 + 4 * hi) * 2;
      const f32x4 cs0 = *(const f32x4*)tp, cs1 = *(const f32x4*)(tp + 4); const float c[4] = {cs0[0], cs0[2], cs1[0], cs1[2]}, sn[4] = {cs0[1], cs0[3], cs1[1], cs1[3]};
      const bf16x8 q = qr[4 + ax]; float o1[4], o2[4];
#pragma unroll
      for (int j = 0; j < 4; ++j) { const float x1 = bf2f((unsigned short)q[j]), x2 = bf2f((unsigned short)q[4 + j]); o1[j] = x1 * c[j] - x2 * sn[j]; o2[j] = x2 * c[j] + x1 * sn[j]; }
      u32x4 w = {cvtpk(o1[0], o1[1]), cvtpk(o1[2], o1[3]), cvtpk(o2[0], o2[1]), cvtpk(o2[2], o2[3])}; qr[4 + ax] = *reinterpret_cast<bf16x8*>(&w); } }
  const bool has2 = tid < 256; const int id2 = has2 ? tid + 512 : tid;
  const int k0r = (tid & 7) + 8 * (tid / 96), k0c = (tid >> 3) % 12, k1r = (id2 & 7) + 8 * (id2 / 96), k1c = (id2 >> 3) % 12;
  const int vr = tid >> 3, vc = (tid & 7) * 8, vst0 = v_st(vr, vc);
  const int kst0 = k0c * 1024 + k0r * 16, kst1 = k1c * 1024 + k1r * 16;
  const bf16_t* k0p = k0c < 8 ? Kh + (long)k0r * LDK + k0c * 8 : Krp + (long)k0r * LDKR + (k0c - 8) * 8; const int k0s = (k0c < 8 ? LDK : LDKR) * KVBLK;
  const bf16_t* k1p = k1c < 8 ? Kh + (long)k1r * LDK + k1c * 8 : Krp + (long)k1r * LDKR + (k1c - 8) * 8; const int k1s = (k1c < 8 ? LDK : LDKR) * KVBLK;
  const lds_cptr vp0 = (lds_cptr)V_lds + v_rd_base(lane);
  auto& sr_ = R.sr_;
#define SLOADP(i, tk, tv, K0P, K1P, VH) do { sr_[i].vs0 = *reinterpret_cast<const bf16x8*>(&(VH)[(long)((tv) * KVBLK + vr) * LDV + vc]); \
    sr_[i].ks0 = *reinterpret_cast<const bf16x8*>((K0P) + (long)(tk) * k0s); sr_[i].ks1 = *reinterpret_cast<const bf16x8*>((K1P) + (long)(tk) * k1s); } while (0)
#define SLOAD(i, tk, tv) SLOADP(i, tk, tv, k0p, k1p, Vh)
#define SWRITEK(b, i) do { *(bf16x8*)(K_lds + (b) * SHM_K + kst0) = sr_[i].ks0; if (has2) *(bf16x8*)(K_lds + (b) * SHM_K + kst1) = sr_[i].ks1; } while (0)
#define SWRITEV(b, i) do { *(bf16x8*)(V_lds + (b) * SHM_V + vst0) = sr_[i].vs0; } while (0)
#define SWAIT() asm volatile("s_waitcnt vmcnt(3)" ::: "memory")
#define RESC(a) do { if (__any((a) < 1.f)) { if (hi == 0) al_l[r32] = (a); asm volatile("s_waitcnt lgkmcnt(0)" ::: "memory"); \
    _Pragma("unroll") for (int d = 0; d < 2; ++d) _Pragma("unroll") for (int r = 0; r < 16; ++r) o[d][r] *= al_l[crow(r, hi)]; } } while (0)
  f32x16 pA0, pA1, pB0, pB1; float alA, alB; bf16x8 pa0, pa1, pa2, pa3; const int NT = seq / KVBLK;
  constexpr int SE = 0, SO = 1;
  bf16x8 kf[12];
  int s0 = 0, s1 = 1, s2 = 2;
#define ROT() do { const int o_ = s0; s0 = s1; s1 = s2; s2 = o_; } while (0)
#define STEP(C0, C1, alC, P0, P1, alP, SP, t) do { \
    SBAR(); qkt(C0, C1, kf, qr, negm); \
    finishSM(P0, P1, alP, l_reg, pa0, pa1, pa2, pa3); SBAR(); \
    SWAIT(); if ((t) + 2 < NT) SWRITEK(s0, SP); if ((t) < NT) SWRITEV(s1, SP);                  \
    if ((t) + 4 < NT) SLOAD(SP, (t) + 4, (t) + 2); else if ((t) + 2 < NT) SLOAD(SP, (t) + 2, (t) + 2); SBAR(); \
    pv_softmax(o, vp0 + s0 * SHM_V, pa0, pa1, pa2, pa3, C0, C1, m_hat, negm, alC); \
    if ((t) + 1 < NT) kload(kf, K_lds + s2 * SHM_K, r32, hi); SBAR(); \
    RESC(alC); __syncthreads(); ROT(); } while (0)
  __syncthreads();
  if (!pre) { SLOAD(SE, 0, 0); SLOAD(SO, 1, 1); R.k2a = *reinterpret_cast<const bf16x8*>(k0p + 2L * k0s); R.k2b = *reinterpret_cast<const bf16x8*>(k1p + 2L * k1s); }
  asm volatile("s_waitcnt vmcnt(0)" ::: "memory");
  SWRITEK(0, SE); SWRITEV(0, SE); SWRITEK(1, SO);
  *(bf16x8*)(K_lds + 2 * SHM_K + kst0) = R.k2a; if (has2) *(bf16x8*)(K_lds + 2 * SHM_K + kst1) = R.k2b;
  SLOAD(SO, 3, 1); SLOAD(SE, 4, 2); __syncthreads();
  kload(kf, K_lds, r32, hi); qkt(pA0, pA1, kf, qr, negm); kload(kf, K_lds + SHM_K, r32, hi);
  { const float rm = rowmax32(pA0, pA1); move_ref(pA0, pA1, rm, m_hat, negm); alA = 1.f; exp16(pA0); }
  __syncthreads();
  int t = 1;
  for (; t + 1 < NT; t += 2) {
    STEP(pB0, pB1, alB, pA0, pA1, alA, SO, t);
    STEP(pA0, pA1, alA, pB0, pB1, alB, SE, t + 1);
  }
  STEP(pB0, pB1, alB, pA0, pA1, alA, SO, t);
  finishSM(pB0, pB1, alB, l_reg, pa0, pa1, pa2, pa3); SBAR();
  if (has_next) {
    int t2 = threadIdx.x; asm volatile("" : "+v"(t2));
    const int w2 = t2 >> 6, l2 = t2 & 63; const long qoff = (long)(w2 * QBLK + (l2 & 31)) * LDQ + (l2 >> 5) * 8;
#pragma unroll
    for (int d0 = 0; d0 < 6; ++d0) qr[d0] = *reinterpret_cast<const bf16x8*>(Qn + qoff + d0 * 16);
    const int j2 = t2 < 256 ? t2 + 512 : t2; const int a0r = (t2 & 7) + 8 * (t2 / 96), a0c = (t2 >> 3) % 12, a1r = (j2 & 7) + 8 * (j2 / 96), a1c = (j2 >> 3) % 12, bvr = t2 >> 3, bvc = (t2 & 7) * 8;
    const bf16_t* k0n = a0c < 8 ? Khn + (long)a0r * LDK + a0c * 8 : Krn + (long)a0r * LDKR + (a0c - 8) * 8; const int s0n = (a0c < 8 ? LDK : LDKR) * KVBLK;
    const bf16_t* k1n = a1c < 8 ? Khn + (long)a1r * LDK + a1c * 8 : Krn + (long)a1r * LDKR + (a1c - 8) * 8; const int s1n = (a1c < 8 ? LDK : LDKR) * KVBLK;
    sr_[SE].vs0 = *reinterpret_cast<const bf16x8*>(&Vhn[(long)bvr * LDV + bvc]); sr_[SE].ks0 = *reinterpret_cast<const bf16x8*>(k0n); sr_[SE].ks1 = *reinterpret_cast<const bf16x8*>(k1n);
    sr_[SO].vs0 = *reinterpret_cast<const bf16x8*>(&Vhn[(long)(KVBLK + bvr) * LDV + bvc]); sr_[SO].ks0 = *reinterpret_cast<const bf16x8*>(k0n + s0n); sr_[SO].ks1 = *reinterpret_cast<const bf16x8*>(k1n + s1n);
    R.k2a = *reinterpret_cast<const bf16x8*>(k0n + 2L * s0n); R.k2b = *reinterpret_cast<const bf16x8*>(k1n + 2L * s1n); }
  else { R.k2a = bf16x8{}; R.k2b = bf16x8{}; }
  SBAR();
  pv_only(o, vp0 + s0 * SHM_V, pa0, pa1, pa2, pa3);
#undef STEP
#undef ROT
#undef SWRITEK
#undef SWRITEV
  if (hi == 0) li_l[r32] = l_reg; asm volatile("s_waitcnt lgkmcnt(0)" ::: "memory");
  float rli[16];
#pragma unroll
  for (int r = 0; r < 16; ++r) rli[r] = __builtin_amdgcn_rcpf(li_l[crow(r, hi)]);
  { bf16_t* stg = (bf16_t*)(lds + OFF_OST) + wid * 2048;
#pragma unroll
    for (int r = 0; r < 16; ++r) { const int orow = crow(r, hi);
#pragma unroll
      for (int d0 = 0; d0 < 2; ++d0) stg[orow * 64 + d0 * 32 + r32] = (bf16_t)(cvtpk(o[d0][r] * rli[r], 0.f) & 0xffffu); }
    asm volatile("s_waitcnt lgkmcnt(0)" ::: "memory");
    bf16_t* Ow = Ob + (long)(wid * QBLK) * LDO;
#pragma unroll
    for (int i = 0; i < 4; ++i) { const int row = i * 8 + (lane >> 3), ch = lane & 7; const u32x4 v = *(const u32x4*)(stg + row * 64 + ch * 8); *(u32x4*)(Ow + (long)row * LDO + ch * 8) = v; } }
#undef SLOAD
#undef SLOADP
#undef SWRITE
#undef SWAIT
#undef RESC
}
#undef SBAR
}

__device__ __forceinline__ int qperm16(int w) { return w < 4 ? w : (w < 8 ? w + 4 : (w < 12 ? w - 4 : w)); }
__device__ __forceinline__ void transpose_item(const float* W, int K, int N, bf16_t* WT, LAS float* scr, int item, int lane, int mode  ) {
    const int nblk = N / 32, kb = item / nblk, nb = item % nblk, k0 = 64 * kb; int n0 = 32 * nb;
    int s0 = n0;
    if (mode == 3) {
        if (nb >= 45) { const int e = nb - 45; n0 = 1024 + 256 * (e >> 2) + 128 + 32 * (e & 3); }
        else if (nb >= 29) { const int e = nb - 29; n0 = 1024 + 256 * (e >> 2) + 32 * (e & 3); }
    }
    if (mode == 2) s0 = (n0 < 512) ? (n0 >> 6) * 128 + (n0 & 63) : ((n0 - 512) >> 6) * 128 + 64 + ((n0 - 512) & 63);
    { f32x4 wv[8]; const int kr = lane >> 3, c4 = (lane & 7) * 4;
#pragma unroll
      for (int i = 0; i < 8; ++i) wv[i] = __builtin_nontemporal_load((const f32x4*)(W + (size_t)(k0 + 8 * i + kr) * N + s0 + c4));
#pragma unroll
      for (int i = 0; i < 8; ++i) { LAS float* d = scr + (8 * i + kr) * 33 + c4; d[0] = wv[i][0]; d[1] = wv[i][1]; d[2] = wv[i][2]; d[3] = wv[i][3]; } }
    asm volatile("s_waitcnt lgkmcnt(0)" ::: "memory");
    const int c = lane & 7;
#pragma unroll
    for (int j = 0; j < 4; ++j) { const int n = (lane >> 3) + 8 * j; int ns = n;
        if (mode == 1) { const int col = n0 + n, d = col % 96; if (d >= 64) ns = (n & 16) | qperm16(n & 15); }
        const LAS float* s = scr + (8 * c) * 33 + ns;
        u32x4 o; o.x = pk2(s[0 * 33], s[1 * 33]); o.y = pk2(s[2 * 33], s[3 * 33]); o.z = pk2(s[4 * 33], s[5 * 33]); o.w = pk2(s[6 * 33], s[7 * 33]);
        *(u32x4*)(WT + (size_t)(n0 + n) * K + k0 + 8 * c) = o; }
    asm volatile("s_waitcnt lgkmcnt(0)" ::: "memory");
}
__device__ __forceinline__ void adaln_item(const float* c, const float* cctx, const float* wmod, const float* bmod, float* MOD, int item, LAS float* sm) {
    const int tid = threadIdx.x;
    for (int i = tid; i < 9 * 1024; i += 512) { const float v = (i < 8192) ? c[i] : cctx[i - 8192]; sm[i] = v / (1.f + expf(-v)); }
    __syncthreads();
    const int col = tid & 31, kg = tid >> 5, n = item * 32 + col;
    float acc[9];
#pragma unroll
    for (int r = 0; r < 9; ++r) acc[r] = 0.f;
#pragma unroll 32
    for (int kk = 0; kk < 64; ++kk) { const int k = kg * 64 + kk; const float w = __builtin_nontemporal_load(wmod + (size_t)k * NMOD + n);
#pragma unroll
        for (int r = 0; r < 9; ++r) acc[r] += sm[r * 1024 + k] * w; }
    LAS float* red = sm + 9 * 1024;
#pragma unroll
    for (int r = 0; r < 9; ++r) red[(kg * 9 + r) * 32 + col] = acc[r];
    __syncthreads();
    if (tid < 288) { const int r = tid >> 5, cc = tid & 31; float s = 0.f;
#pragma unroll
        for (int g2 = 0; g2 < 16; ++g2) s += red[(g2 * 9 + r) * 32 + cc];
        MOD[r * NMOD + item * 32 + cc] = s + bmod[item * 32 + cc]; }
    __syncthreads();
}

#define XB_TMO      128
#define XB_XCNT(j)  (256  + 64 * (j))
#define XB_XSUB(j)  (1280 + 64 * (j))
#define XB_XGEN(j)  (2304 + 64 * (j))
#define XB_TOP      3328
#define XB_TOPGEN   3392
#define XCD_BAR_WORDS 3456
#define ADALN_CNT_WORD 3584
#define XB_SPIN_CAP (1u << 18)

__device__ __forceinline__ unsigned xb_ld(unsigned* p)              { return __hip_atomic_load(p, __ATOMIC_RELAXED, __HIP_MEMORY_SCOPE_AGENT); }
__device__ __forceinline__ unsigned xb_add(unsigned* p, unsigned v) { return __hip_atomic_fetch_add(p, v, __ATOMIC_RELAXED, __HIP_MEMORY_SCOPE_AGENT); }
__device__ __forceinline__ unsigned xb_xcc_id() { return (unsigned)__builtin_amdgcn_s_getreg((3 << 11) | 20) & 0xFu; }
#define XB_SPIN(cond, bar) do { unsigned _sp = 0; while (cond) { __builtin_amdgcn_s_sleep(1); \
    if ((++_sp & 255u) == 0u) { if (xb_ld(&(bar)[XB_TMO])) break; if (_sp > XB_SPIN_CAP) { atomicAdd(&(bar)[XB_TMO], 1u); break; } } } } while (0)

struct XcdBarrier {
    unsigned* bar; unsigned x;
    volatile LAS unsigned* st;
};

__device__ __forceinline__ XcdBarrier xcd_barrier_post(unsigned* bar, volatile LAS unsigned* st) {
    XcdBarrier b; b.bar = bar; b.x = xb_xcc_id(); b.st = st;
    if (threadIdx.x == 0) (void)xb_add(&bar[XB_XCNT(b.x)], 1u);
    return b;
}
__device__ __forceinline__ void xcd_barrier_complete(unsigned* bar, unsigned x, unsigned& nloc, unsigned& nx) {
    const unsigned G = gridDim.x * gridDim.y * gridDim.z;
    unsigned sum, cnt, mine, sp = 0u;
    for (;;) {
        sum = 0u; cnt = 0u; mine = 0u;
#pragma unroll
        for (unsigned j = 0; j < 16; ++j) { const unsigned c = xb_ld(&bar[XB_XCNT(j)]); sum += c; cnt += (c > 0u) ? 1u : 0u; mine = (j == x) ? c : mine; }
        if (sum == G) break;
        __builtin_amdgcn_s_sleep(1);
        if ((++sp & 255u) == 0u) { if (xb_ld(&bar[XB_TMO])) break; if (sp > XB_SPIN_CAP) { atomicAdd(&bar[XB_TMO], 1u); break; } }
    }
    nloc = mine > 0u ? mine : 1u; nx = cnt > 0u ? cnt : 1u;
}

__device__ __forceinline__ void xcd_barrier(const XcdBarrier& b) {
    asm volatile("s_waitcnt vmcnt(0)" ::: "memory");
    __syncthreads();
    if (threadIdx.x == 0) {
        unsigned* bar = b.bar;
        __builtin_amdgcn_s_waitcnt(0);
        unsigned nloc = b.st[0], nx = b.st[1];
        if (nloc == 0u) { xcd_barrier_complete(bar, b.x, nloc, nx); b.st[0] = nloc; b.st[1] = nx; }
        const unsigned old = xb_add(&bar[XB_XSUB(b.x)], 1u);
        const unsigned gen = old / nloc;
        if (old + 1u == (gen + 1u) * nloc) {
            __builtin_amdgcn_fence(__ATOMIC_RELEASE, "agent");
            asm volatile("s_waitcnt vmcnt(0)" ::: "memory");
            const unsigned og = xb_add(&bar[XB_TOP], 1u);
            const unsigned tg = og / nx;
            if (og + 1u == (tg + 1u) * nx) xb_add(&bar[XB_TOPGEN], 1u);
            else XB_SPIN(xb_ld(&bar[XB_TOPGEN]) == tg, bar);
            __builtin_amdgcn_fence(__ATOMIC_ACQUIRE, "agent");
            xb_add(&bar[XB_XGEN(b.x)], 1u);
            asm volatile("s_waitcnt vmcnt(0)" ::: "memory");
        } else {
            XB_SPIN(xb_ld(&bar[XB_XGEN(b.x)]) == gen, bar);
            __builtin_amdgcn_fence(__ATOMIC_ACQUIRE, "agent");
            asm volatile("s_waitcnt vmcnt(0)" ::: "memory");
        }
    }
    __syncthreads();
}

struct Args { const float* in[16]; float* out; unsigned char* ws; };

__global__ void __launch_bounds__(512, 2) fwd_megakernel(Args a) {
    extern __shared__ __attribute__((aligned(16))) unsigned char lds[];
    cg::grid_group grid = cg::this_grid();
    const int G = gridDim.x, bx = blockIdx.x;
    const int vcu = (G % 8 == 0) ? (bx % 8) * (G / 8) + bx / 8 : bx;
    const int NGW = G * 8;
#define PHASE_IDS int tid_ = threadIdx.x; asm volatile("" : "+v"(tid_)); const int tid = tid_, lane = tid & 63, wave = __builtin_amdgcn_readfirstlane(tid >> 6), gw = vcu * 8 + wave; (void)tid; (void)lane; (void)gw;
    LAS unsigned char* ldsl = (LAS unsigned char*)lds;
    unsigned* barw = (unsigned*)(a.ws + WS_BAR);
    volatile LAS unsigned* MISC = (volatile LAS unsigned*)(ldsl + 131072);
    if (threadIdx.x < 4) MISC[threadIdx.x] = 0u;
    __syncthreads();
    if (a.ws == nullptr) grid.sync();
    const XcdBarrier xbar = xcd_barrier_post(barw, MISC);
    const float* x = a.in[0]; const float* cvec = a.in[1]; const float* ctx = a.in[2]; const float* cctx = a.in[3]; const float* w_mod = a.in[4]; const float* b_mod = a.in[5];
    const float* w_in = a.in[6]; const float* q_g = a.in[7]; const float* w_uq = a.in[8]; const float* kv_g = a.in[9]; const float* w_ukv = a.in[10]; const float* conv_w = a.in[11];
    const float* w_out = a.in[12]; const float* w_mlp1 = a.in[13]; const float* w_mlp2 = a.in[14]; const float* fin_g = a.in[15];
    float* out = a.out; unsigned char* ws = a.ws;
    float* MOD = (float*)(ws + WS_MOD); float* TAB = (float*)(ws + WS_TAB);
    unsigned long long* SSQ = (unsigned long long*)(ws + WS_SSQ); float* BIAS2 = (float*)(ws + WS_B2);
    unsigned long long* SSQ2 = (unsigned long long*)(ws + WS_SSQ2); bf16_t* X1b = (bf16_t*)out  ; bf16_t* X2b = (bf16_t*)(ws + WS_XN)  ;
    bf16_t* Win_t = (bf16_t*)(ws + WS_WIN); bf16_t* Wuq_t = (bf16_t*)(ws + WS_WUQ); bf16_t* Wkv_t = (bf16_t*)(ws + WS_WKV); bf16_t* Wo_t = (bf16_t*)(ws + WS_WO);
    bf16_t* W1_t = (bf16_t*)(ws + WS_W1); bf16_t* W2_t = (bf16_t*)(ws + WS_W2);
    bf16_t* XN = (bf16_t*)(ws + WS_XN); bf16_t* AC = (bf16_t*)(ws + WS_AC); bf16_t* Vb = (bf16_t*)(ws + WS_V); bf16_t* Z = (bf16_t*)(ws + WS_Z);
    bf16_t* CQ = (bf16_t*)(ws + WS_CQ); bf16_t* CKV = (bf16_t*)(ws + WS_CKV); bf16_t* Qb = (bf16_t*)(ws + WS_Q); bf16_t* KV2 = (bf16_t*)(ws + WS_KV); bf16_t* KR = (bf16_t*)(ws + WS_KR); bf16_t* Hb = (bf16_t*)(ws + WS_H);

#ifndef PHMASK
#define PHMASK 0xFFFF
#endif
#define PH(n) if ((PHMASK >> (n)) & 1)
    PH(0) {
    PHASE_IDS
    { unsigned ndone = 0u;
      for (int it = vcu; it < NMOD / 32; it += G) { adaln_item(cvec, cctx, w_mod, b_mod, MOD, it, (LAS float*)ldsl); ++ndone; }
      if (ndone) {
          asm volatile("s_waitcnt vmcnt(0)" ::: "memory"); __syncthreads();
          if (tid == 0) { __builtin_amdgcn_fence(__ATOMIC_RELEASE, "agent"); asm volatile("s_waitcnt vmcnt(0)" ::: "memory"); __hip_atomic_fetch_add(barw + ADALN_CNT_WORD, ndone, __ATOMIC_RELAXED, __HIP_MEMORY_SCOPE_AGENT); } } }
    if (vcu == G - 1) { const int pos = tid >> 3, i = tid & 7; const float fr = powf(10000.f, -(float)(2 * i) / 16.f); const float ang = (float)pos * fr; TAB[tid * 2] = cosf(ang); TAB[tid * 2 + 1] = sinf(ang); }
    {
        LAS float* scr = (LAS float*)(ldsl + wave * 16384);
        constexpr int I_IN = (DM / 64) * (INC / 32), I_UQ = (QLR / 64) * (768 / 32), I_KV = (KVLR / 64) * (1024 / 32), I_O = (DM / 64) * (DM / 32), I_1 = (DM / 64) * (DFF / 32), I_2 = (DFF / 64) * (DM / 32);
        constexpr int NIT = I_IN + I_UQ + I_KV + I_O + I_1 + I_2;
        for (int it = gw; it < NIT; it += NGW) {
            int r = it;
            if (r < I_1) { transpose_item(w_mlp1, DM, DFF, W1_t, scr, r, lane, 0); continue; } r -= I_1;
            if (r < I_2) { transpose_item(w_mlp2, DFF, DM, W2_t, scr, r, lane, 0); continue; } r -= I_2;
            if (r < I_IN) { transpose_item(w_in, DM, INC, Win_t, scr, r, lane, 3); continue; } r -= I_IN;
            if (r < I_O) { transpose_item(w_out, DM, DM, Wo_t, scr, r, lane, 0); continue; } r -= I_O;
            if (r < I_UQ) { transpose_item(w_uq, QLR, 768, Wuq_t, scr, r, lane, 1); continue; } r -= I_UQ;
            transpose_item(w_ukv, KVLR, 1024, Wkv_t, scr, r, lane, 2);
        }
        for (int i = gw * 64 + lane; i < (ZP - INC) * DM / 8; i += NGW * 64) *(u32x4*)(Win_t + (size_t)928 * DM + (size_t)i * 8) = (u32x4){0u, 0u, 0u, 0u};
    }
    }
    { if (threadIdx.x == 0) { unsigned sp = 0u; while (__hip_atomic_load(barw + ADALN_CNT_WORD, __ATOMIC_RELAXED, __HIP_MEMORY_SCOPE_AGENT) < (unsigned)(NMOD / 32)) { __builtin_amdgcn_s_sleep(2); if (++sp > (1u << 22)) break; }
        __builtin_amdgcn_fence(__ATOMIC_ACQUIRE, "agent"); asm volatile("s_waitcnt vmcnt(0)" ::: "memory"); }
      __syncthreads(); }

    PH(1) { PHASE_IDS
    for (int r0 = gw; r0 < MROWS; r0 += 2 * NGW) {
        const float* src[2]; const float* md[2]; bool ok[2]; f32x4 v[2][4]; float s[2];
#pragma unroll
        for (int q = 0; q < 2; ++q) { const int r = r0 + q * NGW; ok[q] = r < MROWS; const int rr = ok[q] ? r : r0; const int b = rr / TOK, t = rr - b * TOK;
            src[q] = t < SEQ ? x + ((size_t)b * SEQ + t) * DM : ctx + ((size_t)b * CTX + (t - SEQ)) * DM; md[q] = MOD + (t < SEQ ? b : 8) * NMOD; }
#pragma unroll
        for (int q = 0; q < 2; ++q)
#pragma unroll
            for (int j = 0; j < 4; ++j) v[q][j] = __builtin_nontemporal_load((const f32x4*)src[q] + lane + 64 * j);
#pragma unroll
        for (int q = 0; q < 2; ++q) { s[q] = 0.f;
#pragma unroll
            for (int j = 0; j < 4; ++j) s[q] += (v[q][j].x * v[q][j].x + v[q][j].y * v[q][j].y) + (v[q][j].z * v[q][j].z + v[q][j].w * v[q][j].w); }
#pragma unroll
        for (int q = 0; q < 2; ++q) if (ok[q]) { const int r = r0 + q * NGW; const float rstd = rsqrtf(wave_sum(s[q]) * (1.f / DM) + EPS);
#pragma unroll
            for (int j = 0; j < 4; ++j) { const f32x4 sh = ((const f32x4*)md[q])[lane + 64 * j], sc = ((const f32x4*)(md[q] + DM))[lane + 64 * j]; const f32x4 y = v[q][j] * rstd * (sc + 1.f) + sh;
                u32x2 w; w.x = pk2(y.x, y.y); w.y = pk2(y.z, y.w); *(u32x2*)(XN + (size_t)r * DM + 4 * (lane + 64 * j)) = w; } }
    }
    for (int i = gw * 64 + lane; i < NB * SEQ; i += NGW * 64) { SSQ[i] = 0ull; SSQ2[i] = 0ull; }
    }
    xcd_barrier(xbar);

    PH(2) {
        pg8::Gemm g{XN, Win_t, MROWS, ZP, DM}; Sched S{8, 1024, 1024, G, vcu, 1};
        EpiZ E{Z};
        pg8::gemm_phase<EpiZ, Sched, true, true>(ldsl, g, S, E);
    }
    xcd_barrier(xbar);

    PH(3) {
        constexpr int NC = 8; const bool ctxwg = vcu >= G - NC; const int ctxrow0 = ((vcu - (G - NC)) * 17 + 16) * 256;
        if (ctxwg) {
            pg8::Gemm g{XN, Win_t, MROWS, ZP, DM}; SchedOne S1{(vcu - (G - NC)) * 17 + 16, 1};
            EpiZ E{Z};
            pg8::gemm_phase<EpiZ, SchedOne, true, true>(ldsl, g, S1, E);
            asm volatile("s_waitcnt vmcnt(0)" ::: "memory"); __syncthreads(); __builtin_amdgcn_fence(__ATOMIC_ACQUIRE, "agent");
        }
        PHASE_IDS
        {
    for (int n = vcu * 8 + wave; n < DFF; n += NGW) {
        const u32x4 w0 = *(const u32x4*)(W1_t + (size_t)n * DM + 16 * lane), w1 = *(const u32x4*)(W1_t + (size_t)n * DM + 16 * lane + 8);
        float wv[16];
#pragma unroll
        for (int q = 0; q < 4; ++q) { wv[2 * q] = bflo(w0[q]); wv[2 * q + 1] = bfhi(w0[q]); wv[8 + 2 * q] = bflo(w1[q]); wv[8 + 2 * q + 1] = bfhi(w1[q]); }
#pragma unroll
        for (int b = 0; b < NB; ++b) { const float* sh = MOD + b * NMOD + 3 * DM + 16 * lane; float acc = 0.f;
#pragma unroll
            for (int q = 0; q < 4; ++q) { const f32x4 sv = *(const f32x4*)(sh + 4 * q); acc += (sv[0] * wv[4 * q] + sv[1] * wv[4 * q + 1]) + (sv[2] * wv[4 * q + 2] + sv[3] * wv[4 * q + 3]); }
            acc = wave_sum(acc); if (lane == 0) BIAS2[b * DFF + n] = acc; }
    }
        }
        const int ch0 = 8 * lane;
        float cw[3][8];
#pragma unroll
        for (int k = 0; k < 3; ++k)
#pragma unroll
            for (int j = 0; j < 8; ++j) cw[k][j] = conv_w[k * 512 + ch0 + j];
        if (!ctxwg)
        for (int pi = gw; pi < NB * SEQ / 2; pi += (G - NC) * 8) {
            const int b = pi >> 11, t = (pi & 2047) * 2; const int r = b * TOK + t; const bf16_t* z = Z + (size_t)r * ZW;
            const int p = lane & 15, ax = p >> 3, i = p & 7;
            typedef float f32x2_t __attribute__((ext_vector_type(2)));
            unsigned wk[2]; u32x2 wq[2]; bf16_t k1[2], k2[2]; u32x4 gb[2], uu[4]; f32x2_t cs2[2];
#pragma unroll
            for (int q = 0; q < 2; ++q) { const bf16_t* zq = z + q * ZW; wk[q] = *(const unsigned*)(zq + 256 + 2 * lane); wq[q] = *(const u32x2*)(zq + 4 * lane);
                k1[q] = zq[384 + ax * 16 + i]; k2[q] = zq[384 + ax * 16 + 8 + i]; gb[q] = __builtin_nontemporal_load((const u32x4*)(zq + 416 + ch0));
                uu[1 + q] = *(const u32x4*)(zq + 928 + ch0);
                { const int tq = t + q, pos = ax == 0 ? (tq >> 6) : (tq & 63); cs2[q] = *(const f32x2_t*)(TAB + (pos * 8 + i) * 2); } }
            uu[0] = (u32x4){0u, 0u, 0u, 0u}; uu[3] = uu[0];
            if (t > 0) uu[0] = *(const u32x4*)(z - ZW + 928 + ch0);
            if (t + 2 < SEQ) uu[3] = *(const u32x4*)(z + 2 * ZW + 928 + ch0);
            const float kg0 = kv_g[2 * lane], kg1 = kv_g[2 * lane + 1]; const f32x4 qg = *(const f32x4*)(q_g + 4 * lane);
            float skv[2], sq[2];
#pragma unroll
            for (int q = 0; q < 2; ++q) { const float v0 = bflo(wk[q]), v1 = bfhi(wk[q]); skv[q] = v0 * v0 + v1 * v1;
                const float a0 = bflo(wq[q].x), a1 = bfhi(wq[q].x), a2 = bflo(wq[q].y), a3 = bfhi(wq[q].y); sq[q] = (a0 * a0 + a1 * a1) + (a2 * a2 + a3 * a3); }
#pragma unroll
            for (int q = 0; q < 2; ++q) { skv[q] = wave_sum(skv[q]); sq[q] = wave_sum(sq[q]); }
#pragma unroll
            for (int q = 0; q < 2; ++q) { const int rq = r + q, tq = t + q;
                { const float rstd = rsqrtf(skv[q] * (1.f / KVLR) + EPS); *(unsigned*)(CKV + (size_t)rq * KVLR + 2 * lane) = pk2(bflo(wk[q]) * rstd * kg0, bfhi(wk[q]) * rstd * kg1); }
                { const float rstd = rsqrtf(sq[q] * (1.f / QLR) + EPS); u32x2 o; o.x = pk2(bflo(wq[q].x) * rstd * qg.x, bfhi(wq[q].x) * rstd * qg.y); o.y = pk2(bflo(wq[q].y) * rstd * qg.z, bfhi(wq[q].y) * rstd * qg.w);
                  *(u32x2*)(CQ + (size_t)rq * QLR + 4 * lane) = o; }
                { const float cs = cs2[q].x, sn = cs2[q].y; const float x1 = bf2f(k1[q]), x2 = bf2f(k2[q]);
                  const float o1 = x1 * cs - x2 * sn, o2 = x2 * cs + x1 * sn; const int w1 = i < 4 ? i : i + 4, w2 = i < 4 ? 4 + i : 8 + i;
                  if (lane < 16) { bf16_t* kp = KR + (size_t)rq * 32 + ax * 16; kp[w1] = (bf16_t)(pk2(o1, 0.f) & 0xffffu); kp[w2] = (bf16_t)(pk2(o2, 0.f) & 0xffffu); } }
                u32x4 o;
#pragma unroll
                for (int c = 0; c < 4; ++c) {
                    const float ylo = bflo(gb[q][c]) * (cw[0][2 * c] * bflo(uu[q][c]) + cw[1][2 * c] * bflo(uu[q + 1][c]) + cw[2][2 * c] * bflo(uu[q + 2][c]));
                    const float yhi = bfhi(gb[q][c]) * (cw[0][2 * c + 1] * bfhi(uu[q][c]) + cw[1][2 * c + 1] * bfhi(uu[q + 1][c]) + cw[2][2 * c + 1] * bfhi(uu[q + 2][c]));
                    o[c] = pk2(ylo, yhi); }
                *(u32x4*)(AC + (size_t)rq * DM + 512 + ch0) = o; }
        }
    }
    xcd_barrier(xbar);

    {
        constexpr int NC4 = 8; const bool ctxwg = vcu >= G - NC4; const int ctile = (vcu - (G - NC4)) * 17 + 16, ctxrow0 = ctile * 256; const int GL = G - NC4;
        if (ctxwg) {
            { PHASE_IDS
            for (int it = wave; it < 64; it += 8) {
                const int r = ctxrow0 + it * 4 + (lane >> 4), p = lane & 15; const bf16_t* z = Z + (size_t)r * ZW;
                const u32x4 w = *(const u32x4*)(z + 256 + 8 * p); float v[8];
#pragma unroll
                for (int q = 0; q < 4; ++q) { v[2 * q] = bflo(w[q]); v[2 * q + 1] = bfhi(w[q]); }
                float ss = 0.f;
#pragma unroll
                for (int q = 0; q < 8; ++q) ss += v[q] * v[q];
                ss += __shfl_xor(ss, 1); ss += __shfl_xor(ss, 2); ss += __shfl_xor(ss, 4); ss += __shfl_xor(ss, 8);
                const float rstd = rsqrtf(ss * (1.f / KVLR) + EPS); const f32x4 g0 = *(const f32x4*)(kv_g + 8 * p), g1 = *(const f32x4*)(kv_g + 8 * p + 4);
                u32x4 o; o.x = pk2(v[0] * rstd * g0[0], v[1] * rstd * g0[1]); o.y = pk2(v[2] * rstd * g0[2], v[3] * rstd * g0[3]); o.z = pk2(v[4] * rstd * g1[0], v[5] * rstd * g1[1]); o.w = pk2(v[6] * rstd * g1[2], v[7] * rstd * g1[3]);
                *(u32x4*)(CKV + (size_t)r * KVLR + 8 * p) = o;
                const int ax = p >> 3, i = p & 7; const bf16_t k1 = z[384 + ax * 16 + i], k2 = z[384 + ax * 16 + 8 + i]; const int w1 = i < 4 ? i : i + 4, w2 = i < 4 ? 4 + i : 8 + i;
                { bf16_t* kp = KR + (size_t)r * 32 + ax * 16; kp[w1] = k1; kp[w2] = k2; }
            }
            }
            asm volatile("s_waitcnt vmcnt(0)" ::: "memory"); __syncthreads(); __builtin_amdgcn_fence(__ATOMIC_ACQUIRE, "agent");
        } else {
            pg8::Gemm g{CQ, Wuq_t, MROWS, 768, QLR}; Sched S{3, 384, 384, GL, vcu, 1};
            EpiStore<2> E{Qb, 768, att::C2};
            pg8::gemm_phase<EpiStore<2>, Sched, true, true>(ldsl, g, S, E);
        }
        {
            pg8::Gemm g{CKV, Wkv_t, MROWS, 1024, KVLR};
            const Sched S = ctxwg ? Sched{4, ctile * 4 + 4, ctile * 4 + 4, 1, ctile * 4, 0} : Sched{4, 512, 512, GL, (vcu + 100) % GL, 1};
            EpiStore<0> E{KV2, 1024, 1.f};
            pg8::gemm_phase<EpiStore<0>, Sched, true, true>(ldsl, g, S, E);
        }
    }
    xcd_barrier(xbar);

    PH(6) {
        const int xcd = vcu / (G / 8), slot = vcu % (G / 8);
        att::AttnRegs R; bool pre = false;
        float* tabL = (float*)((char*)lds + 102400);
        { const int t_ = threadIdx.x; *(u32x2*)(tabL + 2 * t_) = *(const u32x2*)(TAB + 2 * t_); }
        __syncthreads();
        const int nun = (G == 256) ? 4 : (1024 - vcu + G - 1) / G;
        for (int i = 0; i < nun; ++i) {
            int bh, qb, bhn, qbn;
            if (G == 256) { bh = i * 16 + xcd * 2 + (slot >> 4); qb = slot & 15; bhn = bh + 16; qbn = qb; }
            else { const int U = i * G + vcu; bh = U >> 4; qb = U & 15; const int Un = U + G; bhn = Un >> 4; qbn = Un & 15; }
            const int b = bh >> 3, h = bh & 7, bn = bhn >> 3, hn = bhn & 7;
            const size_t row0 = (size_t)b * TOK, row0n = (size_t)bn * TOK;
            const bool has_next = (i + 1 < nun);
            att::attn_unit(Qb + (row0 + qb * 256) * 768 + h * 96, KV2 + row0 * 1024 + h * 64, KR + row0 * 32, KV2 + row0 * 1024 + 512 + h * 64, AC + (row0 + qb * 256) * DM + h * 64, TOK, (char*)lds, tabL, qb * 256,
                           R, pre, has_next, Qb + (row0n + qbn * 256) * 768 + hn * 96, KV2 + row0n * 1024 + hn * 64, KR + row0n * 32, KV2 + row0n * 1024 + 512 + hn * 64);
            pre = has_next;
        }
    }
    xcd_barrier(xbar);

    PH(7) {
        pg8::Gemm g{AC, Wo_t, MROWS, DM, DM}; Sched S{4, 512, 512, G, vcu, 1};
        if (G == 256) {
            LAS float* gT = (LAS float*)(ldsl + 131072 + 1024); LAS float* sT = gT + 512;
            { const int t_ = threadIdx.x; const float* mb = MOD + ((vcu >> 6) + 4 * (t_ >> 8)) * NMOD + (vcu & 3) * 256 + (t_ & 255); gT[t_] = mb[2 * DM]; sT[t_] = mb[4 * DM] + 1.f; }
            __syncthreads();
            EpiRes1L EL{x, X1b, gT, sT, XN, SSQ};
            pg8::gemm_phase<EpiRes1L, Sched, true, true>(ldsl, g, S, EL);
        } else {
        EpiRes1 E{x, X1b, MOD, XN, SSQ};
        pg8::gemm_phase<EpiRes1, Sched, true, true>(ldsl, g, S, E); }
    }
    xcd_barrier(xbar);

    PH(9) {
        pg8::Gemm g{XN, W1_t, MROWS, DFF, DM}; EpiMlp1 E{Hb, SSQ, BIAS2};
        if (G == 256) {
            LAS float* rsT = (LAS float*)(ldsl + 131072 + 1024); LAS float* bsT = rsT + 512;
            { const int t_ = threadIdx.x, x_ = vcu >> 5, s_ = vcu & 31;
              const int lrow = (16 * x_ + 8 * (t_ >> 8) + (s_ & 7)) * 256 + (t_ & 255);
              rsT[t_] = rsqrtf((float)SSQ[lrow] * (1.f / (16777216.f * DM)) + EPS);
#pragma unroll
              for (int c = 0; c < 2; ++c) { const int e = t_ + 512 * c, ct = e >> 8; bsT[e] = BIAS2[x_ * DFF + (4 * ct + (s_ >> 3)) * 256 + (e & 255)]; } }
            __syncthreads();
            EpiMlp1L EL{Hb, rsT, bsT};
            SchedUp S{vcu}; pg8::gemm_phase<EpiMlp1L, SchedUp, true, true>(ldsl, g, S, EL); }
        else { Sched S{16, 2048, 2048, G, vcu, 1}; pg8::gemm_phase<EpiMlp1, Sched, true, true>(ldsl, g, S, E); }
    }
    xcd_barrier(xbar);

    PH(10) {
        pg8::Gemm g{Hb, W2_t, MROWS, DM, DFF}; Sched S{4, 512, 512, G, vcu, 1};
        if (G == 256) {
            LAS float* gT = (LAS float*)(ldsl + 131072 + 1024);
            { const int t_ = threadIdx.x; gT[t_] = MOD[((vcu >> 6) + 4 * (t_ >> 8)) * NMOD + 5 * DM + (vcu & 3) * 256 + (t_ & 255)]; }
            __syncthreads();
            EpiRes2L EL{X1b, X2b, gT, SSQ2};
            pg8::gemm_phase<EpiRes2L, Sched, true, true>(ldsl, g, S, EL);
        } else {
        EpiRes2 E{X1b, X2b, MOD + 5 * DM, SSQ2};
        pg8::gemm_phase<EpiRes2, Sched, true, true>(ldsl, g, S, E); }
    }
    xcd_barrier(xbar);

    PH(11) { PHASE_IDS
    for (int r0 = gw; r0 < NB * SEQ; r0 += 2 * NGW) {
        u32x4 w[2][2]; float rs[2]; bool ok[2];
#pragma unroll
        for (int q = 0; q < 2; ++q) { const int r = r0 + q * NGW; ok[q] = r < NB * SEQ; const int rr = ok[q] ? r : r0; const bf16_t* p = X2b + (size_t)rr * DM;
            w[q][0] = __builtin_nontemporal_load((const u32x4*)(p + 8 * lane)); w[q][1] = __builtin_nontemporal_load((const u32x4*)(p + 512 + 8 * lane)); rs[q] = rsqrtf((float)SSQ2[rr] * (1.f / (16777216.f * DM)) + EPS); }
#pragma unroll
        for (int q = 0; q < 2; ++q) if (ok[q]) { float* p = out + (size_t)(r0 + q * NGW) * DM;
#pragma unroll
            for (int hf = 0; hf < 2; ++hf) { const int c = hf * 512 + 8 * lane; const f32x4 g0 = *(const f32x4*)(fin_g + c), g1 = *(const f32x4*)(fin_g + c + 4); const u32x4 v = w[q][hf];
                const f32x4 a = {bflo(v.x), bfhi(v.x), bflo(v.y), bfhi(v.y)}, bq = {bflo(v.z), bfhi(v.z), bflo(v.w), bfhi(v.w)};
                __builtin_nontemporal_store(a * rs[q] * g0, (f32x4*)(p + c)); __builtin_nontemporal_store(bq * rs[q] * g1, (f32x4*)(p + c + 4)); } }
    } }
}

constexpr int LDS_BYTES = 147456;

extern "C" void kernel_launch(void* const* d_in, const int* in_sizes, int n_in, void* d_out, int out_size, void* d_ws, size_t ws_size, hipStream_t stream) {
    static int grid = 0;
    if (grid == 0) {
        if (n_in != 16 || in_sizes[0] != NB * SEQ * DM || out_size != NB * SEQ * DM || ws_size < WS_END) {
            fprintf(stderr, "kernel_launch: unexpected shapes / workspace (n_in %d, ws %zu, need %zu)\n", n_in, ws_size, (size_t)WS_END); grid = -1; return; }
        int dev = 0, cus = 0, per_cu = 0;
        if (hipGetDevice(&dev) != hipSuccess || hipDeviceGetAttribute(&cus, hipDeviceAttributeMultiprocessorCount, dev) != hipSuccess) { grid = -1; return; }
        if (hipFuncSetAttribute((const void*)fwd_megakernel, hipFuncAttributeMaxDynamicSharedMemorySize, LDS_BYTES) != hipSuccess) { fprintf(stderr, "kernel_launch: hipFuncSetAttribute failed\n"); grid = -1; return; }
        if (hipOccupancyMaxActiveBlocksPerMultiprocessor(&per_cu, (const void*)fwd_megakernel, 512, LDS_BYTES) != hipSuccess || per_cu < 1) { fprintf(stderr, "kernel_launch: occupancy query says %d\n", per_cu); per_cu = 1; }
        (void)hipGetLastError();
        grid = cus;
    }
    if (grid < 0) return;
    Args a{};
    for (int i = 0; i < 16; ++i) a.in[i] = (const float*)d_in[i];
    a.out = (float*)d_out; a.ws = (unsigned char*)d_ws;
    void* args[] = {&a};
    if (hipMemsetAsync((char*)d_ws + WS_BAR, 0, 16384, stream) != hipSuccess) { fprintf(stderr, "kernel_launch: hipMemsetAsync of the barrier words failed\n"); return; }
    hipError_t e = hipLaunchCooperativeKernel((const void*)fwd_megakernel, dim3(grid), dim3(512), args, LDS_BYTES, stream);
    if (e != hipSuccess) fprintf(stderr, "cooperative launch failed: %s (grid %d)\n", hipGetErrorString(e), grid);
}
```

```cpp
#include <hip/hip_runtime.h>
#include <hip/hip_cooperative_groups.h>
#include <cstdio>
#include <cstdint>
namespace cg = cooperative_groups;
namespace pg8 {
#define PG8_LAS __attribute__((address_space(3)))
typedef unsigned short bf16_t;
typedef short bf16x8 __attribute__((ext_vector_type(8)));
typedef float f32x4 __attribute__((ext_vector_type(4)));
typedef unsigned u32x4 __attribute__((ext_vector_type(4)));
constexpr int BM = 256, BK = 64, HALF = 128, HTB = HALF * BK * 2  , STAGE_BYTES = 8 * HTB, NXCD = 8, WGM = 8;

__host__ __device__ __forceinline__ int lds_byte(int r, int c) { const int st = (r >> 4) * 2 + (c >> 5), rr = r & 15, cc = c & 31, ob = rr * 64 + cc * 2; return st * 1024 + (ob ^ (((ob >> 9) & 1) << 5)); }
__host__ __device__ __forceinline__ void stage_rc(int b, int& R, int& C) { const int st = b / 1024, sb = b % 1024, swz = sb ^ (((sb >> 9) & 1) << 5); R = (st >> 1) * 16 + swz / 64; C = (st & 1) * 32 + (swz % 64) / 2; }
__host__ __device__ __forceinline__ int perm32(int rho) { const int n = rho >> 4, i = rho & 15; return 8 * (i >> 2) + 4 * n + (i & 3); }

struct Unit { int pm, pn; };
struct Gemm { const bf16_t* A; const bf16_t* Bt; int M, N, K; };
__device__ __forceinline__ unsigned cvt_pk_bf16(float lo, float hi) { unsigned r; asm volatile("v_cvt_pk_bf16_f32 %0, %1, %2" : "=v"(r) : "v"(lo), "v"(hi)); return r; }
typedef float f32x2 __attribute__((ext_vector_type(2)));
template <class Epi, class Sched, bool ALIGN_EPI = false, bool SP2 = false>
__device__ __forceinline__ void gemm_phase(PG8_LAS unsigned char* lds, const Gemm g, const Sched& S, const Epi& E) {
    int tid_ = threadIdx.x; asm volatile("" : "+v"(tid_));
    const int tid = tid_, wid = __builtin_amdgcn_readfirstlane(tid >> 6), lane = tid & 63, wr = wid >> 2, wc = wid & 3, fr = lane & 15, fq = lane >> 4;
    const int K = g.K, nt = K / BK;
    unsigned voffA[2], voffB[2];
#pragma unroll
    for (int i = 0; i < 2; ++i) { int R, C; stage_rc(tid * 16 + i * 8192, R, C); const int Rb = Epi::PERM ? ((R & ~31) + perm32(R & 31)) : R;
        voffA[i] = (unsigned)(R * K + C) * 2u; voffB[i] = (unsigned)(Rb * K + C) * 2u; }
    const size_t kstep = (size_t)(BK * 2);
    const size_t hstep = (size_t)HALF * K * 2;
    const size_t tstep = 2 * hstep;
    const unsigned ldsw = (unsigned)wid * 1024u;
    const int aoff = lds_byte(wr * 64 + fr, fq * 8), boff = lds_byte(wc * 32 + fr, fq * 8);
#define PG8_SA(b, h) (((b) * 2 + (h)) * HTB)
#define PG8_SB(b, h) ((4 + (b) * 2 + (h)) * HTB)
#define PG8_STAGE(bufoff, gbase, voff) do { _Pragma("unroll") for (int _i = 0; _i < 2; ++_i) \
        __builtin_amdgcn_global_load_lds((const unsigned*)((const char*)(gbase) + (voff)[_i]), (PG8_LAS unsigned*)(lds + (bufoff) + ldsw + _i * 8192), 16, 0, 0); } while (0)
#define PG8_LDA(dst, b, h) do { _Pragma("unroll") for (int m = 0; m < 4; ++m) _Pragma("unroll") for (int k = 0; k < 2; ++k) dst[m][k] = *(const PG8_LAS bf16x8*)(lds + PG8_SA(b, h) + aoff + m * 2048 + k * 1024); } while (0)
#define PG8_LDB(dst, b, h) do { _Pragma("unroll") for (int n = 0; n < 2; ++n) _Pragma("unroll") for (int k = 0; k < 2; ++k) dst[n][k] = *(const PG8_LAS bf16x8*)(lds + PG8_SB(b, h) + boff + n * 2048 + k * 1024); } while (0)
#define PG8_MMA(ai, bj, At, Bt) do { __builtin_amdgcn_s_setprio(1); _Pragma("unroll") for (int m = 0; m < 4; ++m) _Pragma("unroll") for (int n = 0; n < 2; ++n) _Pragma("unroll") for (int k = 0; k < 2; ++k) \
        acc[ai][bj][m][n] = __builtin_amdgcn_mfma_f32_16x16x32_bf16(Bt[n][k], At[m][k], acc[ai][bj][m][n], 0, 0, 0); __builtin_amdgcn_s_setprio(0); } while (0)
#define PG8_WAIT_V(n) asm volatile("s_waitcnt vmcnt(" #n ")" ::: "memory")
#define PG8_WAIT_L(n) asm volatile("s_waitcnt lgkmcnt(" #n ")" ::: "memory")
#define PG8_BAR __builtin_amdgcn_s_barrier()
#define PG8_SCHED __builtin_amdgcn_sched_barrier(0)
    Unit cur, nxt; int ui = 0;
    if (!S.next(0, cur)) return;
    f32x4 acc[2][2][4][2];
#pragma unroll
    for (int a = 0; a < 2; ++a)
#pragma unroll
        for (int b = 0; b < 2; ++b)
#pragma unroll
            for (int m = 0; m < 4; ++m)
#pragma unroll
                for (int n = 0; n < 2; ++n) acc[a][b][m][n] = (f32x4){0.f, 0.f, 0.f, 0.f};
    bf16x8 At[4][2], B0[2][2], B1[2][2];
    const char* cA = (const char*)g.A + (size_t)cur.pm * tstep; const char* cB = (const char*)g.Bt + (size_t)cur.pn * tstep;
    S.a_ready(cur);
    if constexpr (SP2) {
        PG8_STAGE(PG8_SB(0, 0), cB, voffB); PG8_STAGE(PG8_SB(0, 1), cB + hstep, voffB); PG8_STAGE(PG8_SA(0, 0), cA, voffA); PG8_STAGE(PG8_SA(0, 1), cA + hstep, voffA);
        if (wr == 1) PG8_BAR;
        PG8_WAIT_V(2); PG8_BAR;
        PG8_STAGE(PG8_SB(1, 0), cB + kstep, voffB); PG8_STAGE(PG8_SA(1, 0), cA + kstep, voffA); PG8_STAGE(PG8_SB(1, 1), cB + hstep + kstep, voffB);
        PG8_WAIT_V(6); PG8_BAR;
    } else {
        PG8_STAGE(PG8_SB(0, 0), cB, voffB); PG8_STAGE(PG8_SA(0, 0), cA, voffA); PG8_STAGE(PG8_SB(0, 1), cB + hstep, voffB); PG8_STAGE(PG8_SA(0, 1), cA + hstep, voffA);
        if (wr == 1) PG8_BAR;
        PG8_WAIT_V(4); PG8_BAR;
        PG8_STAGE(PG8_SB(1, 0), cB + kstep, voffB); PG8_STAGE(PG8_SA(1, 0), cA + kstep, voffA); PG8_STAGE(PG8_SB(1, 1), cB + hstep + kstep, voffB);
        PG8_WAIT_V(6); PG8_BAR;
    }
    for (;;) {
        const bool has_next = S.next(ui + 1, nxt);
        const char* nA = has_next ? (const char*)g.A + (size_t)nxt.pm * tstep : cA; const char* nB = has_next ? (const char*)g.Bt + (size_t)nxt.pn * tstep : cB;
#pragma clang loop unroll(disable)
        for (int t = 0; t < nt; t += 2) {
            const bool last = (t == nt - 2);
            const char* a1 = cA + (size_t)(t + 1) * kstep;
            const char* a2 = last ? nA : cA + (size_t)(t + 2) * kstep; const char* b2 = last ? nB : cB + (size_t)(t + 2) * kstep;
            const char* a3 = a2 + kstep; const char* b3 = b2 + kstep;
            if (last && has_next) S.a_ready(nxt);
            if constexpr (SP2) {
            PG8_LDB(B0, 0, 0); PG8_LDB(B1, 0, 1); PG8_SCHED; PG8_LDA(At, 0, 0); PG8_STAGE(PG8_SA(1, 1), a1 + hstep, voffA);
            PG8_WAIT_V(8); PG8_WAIT_L(0); PG8_BAR; PG8_MMA(0, 0, At, B0); PG8_MMA(0, 1, At, B1); PG8_BAR; PG8_SCHED;
            PG8_LDA(At, 0, 1); PG8_STAGE(PG8_SB(0, 0), b2, voffB); PG8_STAGE(PG8_SB(0, 1), b2 + hstep, voffB); PG8_STAGE(PG8_SA(0, 0), a2, voffA);
            PG8_WAIT_V(8); PG8_WAIT_L(0); PG8_BAR; PG8_MMA(1, 0, At, B0); PG8_MMA(1, 1, At, B1); PG8_BAR; PG8_SCHED;
            PG8_LDB(B0, 1, 0); PG8_LDB(B1, 1, 1); PG8_SCHED; PG8_LDA(At, 1, 0); PG8_STAGE(PG8_SA(0, 1), a2 + hstep, voffA);
            PG8_WAIT_V(8); PG8_WAIT_L(0); PG8_BAR; PG8_MMA(0, 0, At, B0); PG8_MMA(0, 1, At, B1); PG8_BAR; PG8_SCHED;
            PG8_LDA(At, 1, 1); PG8_STAGE(PG8_SB(1, 0), b3, voffB); PG8_STAGE(PG8_SB(1, 1), b3 + hstep, voffB); PG8_STAGE(PG8_SA(1, 0), a3, voffA);
            PG8_WAIT_V(8); PG8_WAIT_L(0); PG8_BAR; PG8_MMA(1, 0, At, B0); PG8_MMA(1, 1, At, B1); PG8_BAR; PG8_SCHED;
            } else {
            PG8_LDB(B0, 0, 0); PG8_SCHED; PG8_LDA(At, 0, 0); PG8_STAGE(PG8_SA(1, 1), a1 + hstep, voffA);
            PG8_WAIT_L(8); PG8_BAR; PG8_WAIT_L(0); PG8_MMA(0, 0, At, B0); PG8_BAR; PG8_SCHED;
            PG8_LDB(B1, 0, 1); PG8_STAGE(PG8_SB(0, 0), b2, voffB);
            PG8_BAR; PG8_WAIT_L(0); PG8_MMA(0, 1, At, B1); PG8_BAR;
            PG8_LDA(At, 0, 1); PG8_STAGE(PG8_SA(0, 0), a2, voffA);
            PG8_BAR; PG8_WAIT_L(0); PG8_MMA(1, 0, At, B0); PG8_BAR; PG8_SCHED;
            PG8_STAGE(PG8_SB(0, 1), b2 + hstep, voffB);
            PG8_WAIT_V(6); PG8_BAR; PG8_MMA(1, 1, At, B1); PG8_BAR;
            PG8_LDB(B0, 1, 0); PG8_SCHED; PG8_LDA(At, 1, 0); PG8_STAGE(PG8_SA(0, 1), a2 + hstep, voffA);
            PG8_WAIT_L(8); PG8_BAR; PG8_WAIT_L(0); PG8_MMA(0, 0, At, B0); PG8_BAR; PG8_SCHED;
            PG8_LDB(B1, 1, 1); PG8_STAGE(PG8_SB(1, 0), b3, voffB);
            PG8_BAR; PG8_WAIT_L(0); PG8_MMA(0, 1, At, B1); PG8_BAR;
            PG8_LDA(At, 1, 1); PG8_STAGE(PG8_SA(1, 0), a3, voffA);
            PG8_BAR; PG8_WAIT_L(0); PG8_MMA(1, 0, At, B0); PG8_BAR; PG8_SCHED;
            PG8_STAGE(PG8_SB(1, 1), b3 + hstep, voffB);
            PG8_WAIT_V(6); PG8_BAR; PG8_MMA(1, 1, At, B1); PG8_BAR;
            }
        }
        if constexpr (ALIGN_EPI) { if (wr == 0) PG8_BAR; }
        if constexpr (!Epi::AFTER_DRAIN) { E(acc, cur, wr, wc, fr, fq); S.done(cur); }
        if (!has_next) break;
#pragma unroll
        for (int a = 0; a < 2; ++a)
#pragma unroll
            for (int b = 0; b < 2; ++b)
#pragma unroll
                for (int m = 0; m < 4; ++m)
#pragma unroll
                    for (int n = 0; n < 2; ++n) acc[a][b][m][n] = (f32x4){0.f, 0.f, 0.f, 0.f};
        cur = nxt; cA = nA; cB = nB; ++ui;
        if constexpr (ALIGN_EPI) { if (wr == 1) PG8_BAR; }
    }
    PG8_WAIT_V(0);
    if constexpr (!ALIGN_EPI) { if (wr == 0) PG8_BAR; }
    PG8_BAR;
    if constexpr (Epi::AFTER_DRAIN) { E.fused(acc, cur, wr, wc, fr, fq, lds, wid, lane); S.done(cur); }
#undef PG8_SA
#undef PG8_SB
#undef PG8_STAGE
#undef PG8_LDA
#undef PG8_LDB
#undef PG8_MMA
#undef PG8_WAIT_V
#undef PG8_WAIT_L
#undef PG8_BAR
#undef PG8_SCHED
}
}

constexpr int DM = 1024, NB = 8, SEQ = 4096, CTX = 256, TOK = SEQ + CTX  , MROWS = NB * TOK  ;
constexpr int NHEAD = 8, DQK = 96, DV = 64, QLR = 256, KVLR = 128, INC = 1952, ZP = 2048  , ZW = 1536  , DFF = 4096, NMOD = 6 * DM;
constexpr float EPS = 1e-6f;
typedef pg8::bf16_t bf16_t;
typedef pg8::f32x4 f32x4;
typedef pg8::u32x4 u32x4;
typedef pg8::bf16x8 bf16x8;
typedef unsigned u32x2 __attribute__((ext_vector_type(2)));
#define LAS __attribute__((address_space(3)))

constexpr size_t MiB = 1u << 20;
constexpr size_t WS_MOD = 0, WS_TAB = 512 * 1024, WS_BAR = 768 * 1024, WS_SSQ = 256 * 1024  , WS_B2 = 5 * MiB + 768 * 1024  ;
constexpr size_t WS_WIN = 1 * MiB, WS_WUQ = 5 * MiB, WS_WKV = 5 * MiB + 512 * 1024, WS_WO = 6 * MiB, WS_W1 = 8 * MiB, WS_W2 = 16 * MiB;
constexpr size_t WS_XN = 24 * MiB, WS_AC = 92 * MiB, WS_V = 160 * MiB, WS_R = 194 * MiB;
constexpr size_t WS_Z = WS_R, WS_CQ = WS_R + 136 * MiB, WS_CKV = WS_R + 153 * MiB, WS_Q = WS_R + 162 * MiB, WS_K = WS_R + 213 * MiB, WS_H = WS_R;
constexpr size_t WS_KV = WS_R + 213 * MiB  , WS_KR = WS_V  , WS_SSQ2 = WS_V + 4 * MiB  ;
constexpr size_t WS_END = WS_R + 282 * MiB;

__device__ __forceinline__ float bf2f(unsigned short h) { return __uint_as_float(((unsigned)h) << 16); }
__device__ __forceinline__ float bflo(unsigned w) { return __uint_as_float(w << 16); }
__device__ __forceinline__ float bfhi(unsigned w) { return __uint_as_float(w & 0xffff0000u); }
__device__ __forceinline__ unsigned pk2(float lo, float hi) { return pg8::cvt_pk_bf16(lo, hi); }
#define DPP_ADD(v, CTRL) ((v) + __builtin_bit_cast(float, __builtin_amdgcn_update_dpp(0, __builtin_bit_cast(int, (v)), (CTRL), 0xf, 0xf, true)))
__device__ __forceinline__ float wave_sum(float v) {
    v = DPP_ADD(v, 0xB1);
    v = DPP_ADD(v, 0x4E);
    v = DPP_ADD(v, 0x141);
    v = DPP_ADD(v, 0x140);
    const int iv = __builtin_bit_cast(int, v);
    const float r0 = __builtin_bit_cast(float, __builtin_amdgcn_readlane(iv, 0)), r1 = __builtin_bit_cast(float, __builtin_amdgcn_readlane(iv, 16));
    const float r2 = __builtin_bit_cast(float, __builtin_amdgcn_readlane(iv, 32)), r3 = __builtin_bit_cast(float, __builtin_amdgcn_readlane(iv, 48));
    return (r0 + r1) + (r2 + r3);
}

struct Sched {
    int nN, nU, nUlat, G, v, latmap;
    __device__ __forceinline__ bool next(int i, pg8::Unit& u) const {
        const int U = i * G + v; if (U >= nU) return false;
        if (U < nUlat) { const int l = U / nN; u.pn = U - l * nN; u.pm = latmap ? l + (l >> 4) : l; }
        else { const int b = U - nUlat; u.pm = b * 17 + 16; u.pn = 1; }
        return true;
    }
    __device__ __forceinline__ void a_ready(const pg8::Unit&) const {}
    __device__ __forceinline__ void done(const pg8::Unit&) const {}
};

struct SchedUp {
    int v;
    __device__ __forceinline__ bool next(int i, pg8::Unit& u) const {
        if (i >= 8) return false;
        const int x = v >> 5, s = v & 31; const int l = 16 * x + 8 * (i >> 2) + (s & 7); u.pn = 4 * (i & 3) + (s >> 3); u.pm = l + (l >> 4); return true;
    }
    __device__ __forceinline__ void a_ready(const pg8::Unit&) const {}
    __device__ __forceinline__ void done(const pg8::Unit&) const {}
};
struct SchedRow {
    int pm, n;
    __device__ __forceinline__ bool next(int i, pg8::Unit& u) const { if (i >= n) return false; u.pm = pm; u.pn = i; return true; }
    __device__ __forceinline__ void a_ready(const pg8::Unit&) const {}
    __device__ __forceinline__ void done(const pg8::Unit&) const {}
};
struct SchedOne {
    int pm, pn;
    __device__ __forceinline__ bool next(int i, pg8::Unit& u) const { if (i) return false; u.pm = pm; u.pn = pn; return true; }
    __device__ __forceinline__ void a_ready(const pg8::Unit&) const {}
    __device__ __forceinline__ void done(const pg8::Unit&) const {}
};
template <int ACT  > struct EpiStore {
    static constexpr bool PERM = true, AFTER_DRAIN = false;
    bf16_t* O; int ldc; float sc;
    __device__ __forceinline__ void operator()(const f32x4 (&acc)[2][2][4][2], const pg8::Unit& u, int wr, int wc, int fr_, int fq_) const {
        int fr = fr_, fq = fq_; asm volatile("" : "+v"(fr), "+v"(fq));
        const int row0 = u.pm * 256 + wr * 64 + fr, col0 = u.pn * 256 + wc * 32 + 8 * fq;
#pragma unroll
        for (int ai = 0; ai < 2; ++ai)
#pragma unroll
            for (int m = 0; m < 4; ++m) { bf16_t* rowp = O + (size_t)(row0 + ai * 128 + m * 16) * ldc + col0;
#pragma unroll
                for (int bj = 0; bj < 2; ++bj) { f32x4 v0 = acc[ai][bj][m][0], v1 = acc[ai][bj][m][1];
                    if (ACT == 1) {
#pragma unroll
                        for (int j = 0; j < 4; ++j) { float a = fmaxf(v0[j], 0.f), b = fmaxf(v1[j], 0.f); v0[j] = a * a; v1[j] = b * b; } }
                    if (ACT == 2) { v0 = v0 * sc; v1 = v1 * sc; }
                    u32x4 w; w.x = pk2(v0[0], v0[1]); w.y = pk2(v0[2], v0[3]); w.z = pk2(v1[0], v1[1]); w.w = pk2(v1[2], v1[3]);
                    *(u32x4*)(rowp + bj * 128) = w; } }
    }
};
struct EpiRes2 {
    static constexpr bool PERM = true, AFTER_DRAIN = false;
    const bf16_t* x1b; bf16_t* x2b; const float* gate; unsigned long long* ssq;
    __device__ __forceinline__ void operator()(const f32x4 (&acc)[2][2][4][2], const pg8::Unit& u, int wr, int wc, int fr_, int fq_) const {
        int fr = fr_, fq = fq_; asm volatile("" : "+v"(fr), "+v"(fq));
        const int b = u.pm / 17; const int orow0 = (u.pm - b) * 256 + wr * 64 + fr;
        float ss[2][4];
#pragma unroll
        for (int ai = 0; ai < 2; ++ai)
#pragma unroll
            for (int m = 0; m < 4; ++m) ss[ai][m] = 0.f;
#pragma unroll
        for (int bj = 0; bj < 2; ++bj) {
            const int col0 = u.pn * 256 + bj * 128 + wc * 32 + 8 * fq;
            const f32x4 g0 = *(const f32x4*)(gate + b * NMOD + col0), g1 = *(const f32x4*)(gate + b * NMOD + col0 + 4);
            u32x4 xr[2][4];
#pragma unroll
            for (int ai = 0; ai < 2; ++ai)
#pragma unroll
                for (int m = 0; m < 4; ++m) xr[ai][m] = __builtin_nontemporal_load((const u32x4*)(x1b + (size_t)(orow0 + ai * 128 + m * 16) * DM + col0));
#pragma unroll
            for (int ai = 0; ai < 2; ++ai)
#pragma unroll
                for (int m = 0; m < 4; ++m) { const size_t off = (size_t)(orow0 + ai * 128 + m * 16) * DM + col0;
                    const u32x4 xw = xr[ai][m];
                    const f32x4 x0 = {bflo(xw.x), bfhi(xw.x), bflo(xw.y), bfhi(xw.y)}, x1 = {bflo(xw.z), bfhi(xw.z), bflo(xw.w), bfhi(xw.w)};
                    const f32x4 y0 = x0 + g0 * acc[ai][bj][m][0], y1 = x1 + g1 * acc[ai][bj][m][1];
                    ss[ai][m] += ((y0[0] * y0[0] + y0[1] * y0[1]) + (y0[2] * y0[2] + y0[3] * y0[3])) + ((y1[0] * y1[0] + y1[1] * y1[1]) + (y1[2] * y1[2] + y1[3] * y1[3]));
                    u32x4 w; w.x = pk2(y0[0], y0[1]); w.y = pk2(y0[2], y0[3]); w.z = pk2(y1[0], y1[1]); w.w = pk2(y1[2], y1[3]);
                    *(u32x4*)(x2b + off) = w; } }
#pragma unroll
        for (int ai = 0; ai < 2; ++ai)
#pragma unroll
            for (int m = 0; m < 4; ++m) { float v = ss[ai][m]; v += __shfl_xor(v, 16); v += __shfl_xor(v, 32);
                if (fq == 0) __hip_atomic_fetch_add(ssq + orow0 + ai * 128 + m * 16, (unsigned long long)(v * 16777216.f), __ATOMIC_RELAXED, __HIP_MEMORY_SCOPE_AGENT); }
    }
};
struct EpiZ {
    static constexpr bool PERM = true, AFTER_DRAIN = false;
    bf16_t* O;
    __device__ __forceinline__ void operator()(const f32x4 (&acc)[2][2][4][2], const pg8::Unit& u, int wr, int wc, int fr_, int fq_) const {
        int fr = fr_, fq = fq_; asm volatile("" : "+v"(fr), "+v"(fq));
        const int row0 = u.pm * 256 + wr * 64 + fr;
        if (u.pn < 4) {
#pragma unroll
            for (int bj = 0; bj < 2; ++bj) { const int col0 = u.pn * 256 + bj * 128 + wc * 32 + 8 * fq;
                if (col0 < 928) {
#pragma unroll
                    for (int ai = 0; ai < 2; ++ai)
#pragma unroll
                        for (int m = 0; m < 4; ++m) { const f32x4 v0 = acc[ai][bj][m][0], v1 = acc[ai][bj][m][1];
                            u32x4 w; w.x = pk2(v0[0], v0[1]); w.y = pk2(v0[2], v0[3]); w.z = pk2(v1[0], v1[1]); w.w = pk2(v1[2], v1[3]);
                            *(u32x4*)(O + (size_t)(row0 + ai * 128 + m * 16) * ZW + col0) = w; } } }
        } else {
            const int col0 = 928 + (u.pn - 4) * 128 + wc * 32 + 8 * fq;
#pragma unroll
            for (int ai = 0; ai < 2; ++ai)
#pragma unroll
                for (int m = 0; m < 4; ++m) { const f32x4 v0 = acc[ai][0][m][0] * acc[ai][1][m][0], v1 = acc[ai][0][m][1] * acc[ai][1][m][1];
                    u32x4 w; w.x = pk2(v0[0], v0[1]); w.y = pk2(v0[2], v0[3]); w.z = pk2(v1[0], v1[1]); w.w = pk2(v1[2], v1[3]);
                    *(u32x4*)(O + (size_t)(row0 + ai * 128 + m * 16) * ZW + col0) = w; }
        }
    }
};
struct EpiRes1 {
    static constexpr bool PERM = true, AFTER_DRAIN = false;
    const float* x; bf16_t* x1b; const float* mod; bf16_t* xn; unsigned long long* ssq;
    __device__ __forceinline__ void operator()(const f32x4 (&acc)[2][2][4][2], const pg8::Unit& u, int wr, int wc, int fr_, int fq_) const {
        int fr = fr_, fq = fq_; asm volatile("" : "+v"(fr), "+v"(fq));
        const int b = u.pm / 17; const int orow0 = (u.pm - b) * 256 + wr * 64 + fr, crow0 = u.pm * 256 + wr * 64 + fr;
        float ss[2][4];
#pragma unroll
        for (int ai = 0; ai < 2; ++ai)
#pragma unroll
            for (int m = 0; m < 4; ++m) ss[ai][m] = 0.f;
#pragma unroll
        for (int bj = 0; bj < 2; ++bj) {
            const int col0 = u.pn * 256 + bj * 128 + wc * 32 + 8 * fq; const float* mb = mod + b * NMOD + col0;
            const f32x4 g0 = *(const f32x4*)(mb + 2 * DM), g1 = *(const f32x4*)(mb + 2 * DM + 4); const f32x4 s0 = *(const f32x4*)(mb + 4 * DM) + 1.f, s1 = *(const f32x4*)(mb + 4 * DM + 4) + 1.f;
#pragma unroll
            for (int ai = 0; ai < 2; ++ai) {
                f32x4 xr0[4], xr1[4];
#pragma unroll
                for (int m = 0; m < 4; ++m) { const size_t off = (size_t)(orow0 + ai * 128 + m * 16) * DM + col0;
                    xr0[m] = __builtin_nontemporal_load((const f32x4*)(x + off)); xr1[m] = __builtin_nontemporal_load((const f32x4*)(x + off + 4)); }
#pragma unroll
                for (int m = 0; m < 4; ++m) { const int ro = ai * 128 + m * 16; const size_t off = (size_t)(orow0 + ro) * DM + col0;
                    const f32x4 x0 = xr0[m], x1 = xr1[m];
                    const f32x4 y0 = x0 + g0 * acc[ai][bj][m][0], y1 = x1 + g1 * acc[ai][bj][m][1];
                    { u32x4 w1; w1.x = pk2(y0[0], y0[1]); w1.y = pk2(y0[2], y0[3]); w1.z = pk2(y1[0], y1[1]); w1.w = pk2(y1[2], y1[3]); *(u32x4*)(x1b + off) = w1; }
                    ss[ai][m] += ((y0[0] * y0[0] + y0[1] * y0[1]) + (y0[2] * y0[2] + y0[3] * y0[3])) + ((y1[0] * y1[0] + y1[1] * y1[1]) + (y1[2] * y1[2] + y1[3] * y1[3]));
                    const f32x4 a0 = y0 * s0, a1 = y1 * s1;
                    u32x4 w; w.x = pk2(a0[0], a0[1]); w.y = pk2(a0[2], a0[3]); w.z = pk2(a1[0], a1[1]); w.w = pk2(a1[2], a1[3]);
                    *(u32x4*)(xn + (size_t)(crow0 + ro) * DM + col0) = w; } } }
#pragma unroll
        for (int ai = 0; ai < 2; ++ai)
#pragma unroll
            for (int m = 0; m < 4; ++m) { float v = ss[ai][m]; v += __shfl_xor(v, 16); v += __shfl_xor(v, 32);
                if (fq == 0) __hip_atomic_fetch_add(ssq + orow0 + ai * 128 + m * 16, (unsigned long long)(v * 16777216.f), __ATOMIC_RELAXED, __HIP_MEMORY_SCOPE_AGENT); }
    }
};
struct EpiMlp1 {
    static constexpr bool PERM = true, AFTER_DRAIN = false;
    bf16_t* O; const unsigned long long* ssq; const float* bias2;
    __device__ __forceinline__ void operator()(const f32x4 (&acc)[2][2][4][2], const pg8::Unit& u, int wr, int wc, int fr_, int fq_) const {
        int fr = fr_, fq = fq_; asm volatile("" : "+v"(fr), "+v"(fq));
        const int b = u.pm / 17; const int orow0 = (u.pm - b) * 256 + wr * 64 + fr, crow0 = u.pm * 256 + wr * 64 + fr;
        float rs[2][4];
#pragma unroll
        for (int ai = 0; ai < 2; ++ai)
#pragma unroll
            for (int m = 0; m < 4; ++m) rs[ai][m] = rsqrtf((float)ssq[orow0 + ai * 128 + m * 16] * (1.f / (16777216.f * DM)) + EPS);
#pragma unroll
        for (int bj = 0; bj < 2; ++bj) {
            const int col0 = u.pn * 256 + bj * 128 + wc * 32 + 8 * fq;
            const f32x4 b0 = *(const f32x4*)(bias2 + b * DFF + col0), b1 = *(const f32x4*)(bias2 + b * DFF + col0 + 4);
#pragma unroll
            for (int ai = 0; ai < 2; ++ai)
#pragma unroll
                for (int m = 0; m < 4; ++m) { f32x4 v0 = acc[ai][bj][m][0] * rs[ai][m] + b0, v1 = acc[ai][bj][m][1] * rs[ai][m] + b1;
#pragma unroll
                    for (int j = 0; j < 4; ++j) { const float p = fmaxf(v0[j], 0.f), q = fmaxf(v1[j], 0.f); v0[j] = p * p; v1[j] = q * q; }
                    u32x4 w; w.x = pk2(v0[0], v0[1]); w.y = pk2(v0[2], v0[3]); w.z = pk2(v1[0], v1[1]); w.w = pk2(v1[2], v1[3]);
                    *(u32x4*)(O + (size_t)(crow0 + ai * 128 + m * 16) * DFF + col0) = w; } }
    }
};

struct EpiMlp1L {
    static constexpr bool PERM = true, AFTER_DRAIN = false;
    bf16_t* O; const LAS float* rsT; const LAS float* bsT;
    __device__ __forceinline__ void operator()(const f32x4 (&acc)[2][2][4][2], const pg8::Unit& u, int wr, int wc, int fr_, int fq_) const {
        int fr = fr_, fq = fq_; asm volatile("" : "+v"(fr), "+v"(fq));
        const int b = u.pm / 17; const int l = u.pm - b; const int crow0 = u.pm * 256 + wr * 64 + fr;
        const LAS float* rp = rsT + ((l >> 3) & 1) * 256 + wr * 64 + fr; const LAS float* bp = bsT + (u.pn >> 2) * 256 + wc * 32 + 8 * fq;
        float rs[2][4];
#pragma unroll
        for (int ai = 0; ai < 2; ++ai)
#pragma unroll
            for (int m = 0; m < 4; ++m) rs[ai][m] = rp[ai * 128 + m * 16];
#pragma unroll
        for (int bj = 0; bj < 2; ++bj) {
            const int col0 = u.pn * 256 + bj * 128 + wc * 32 + 8 * fq;
            const f32x4 b0 = *(const LAS f32x4*)(bp + bj * 128), b1 = *(const LAS f32x4*)(bp + bj * 128 + 4);
#pragma unroll
            for (int ai = 0; ai < 2; ++ai)
#pragma unroll
                for (int m = 0; m < 4; ++m) { f32x4 v0 = acc[ai][bj][m][0] * rs[ai][m] + b0, v1 = acc[ai][bj][m][1] * rs[ai][m] + b1;
#pragma unroll
                    for (int j = 0; j < 4; ++j) { const float p = fmaxf(v0[j], 0.f), q = fmaxf(v1[j], 0.f); v0[j] = p * p; v1[j] = q * q; }
                    u32x4 w; w.x = pk2(v0[0], v0[1]); w.y = pk2(v0[2], v0[3]); w.z = pk2(v1[0], v1[1]); w.w = pk2(v1[2], v1[3]);
                    *(u32x4*)(O + (size_t)(crow0 + ai * 128 + m * 16) * DFF + col0) = w; } }
    }
};

struct EpiRes1L {
    static constexpr bool PERM = true, AFTER_DRAIN = false;
    const float* x; bf16_t* x1b; const LAS float* gT; const LAS float* sT; bf16_t* xn; unsigned long long* ssq;
    __device__ __forceinline__ void operator()(const f32x4 (&acc)[2][2][4][2], const pg8::Unit& u, int wr, int wc, int fr_, int fq_) const {
        int fr = fr_, fq = fq_; asm volatile("" : "+v"(fr), "+v"(fq));
        const int b = u.pm / 17; const int orow0 = (u.pm - b) * 256 + wr * 64 + fr, crow0 = u.pm * 256 + wr * 64 + fr;
        float ss[2][4];
#pragma unroll
        for (int ai = 0; ai < 2; ++ai)
#pragma unroll
            for (int m = 0; m < 4; ++m) ss[ai][m] = 0.f;
#pragma unroll
        for (int bj = 0; bj < 2; ++bj) {
            const int col0 = u.pn * 256 + bj * 128 + wc * 32 + 8 * fq; const int ti = (((u.pm - b) >> 6) & 1) * 256 + bj * 128 + wc * 32 + 8 * fq;
            const f32x4 g0 = *(const LAS f32x4*)(gT + ti), g1 = *(const LAS f32x4*)(gT + ti + 4); const f32x4 s0 = *(const LAS f32x4*)(sT + ti), s1 = *(const LAS f32x4*)(sT + ti + 4);
#pragma unroll
            for (int ai = 0; ai < 2; ++ai) {
                f32x4 xr0[4], xr1[4];
#pragma unroll
                for (int m = 0; m < 4; ++m) { const size_t off = (size_t)(orow0 + ai * 128 + m * 16) * DM + col0;
                    xr0[m] = __builtin_nontemporal_load((const f32x4*)(x + off)); xr1[m] = __builtin_nontemporal_load((const f32x4*)(x + off + 4)); }
#pragma unroll
                for (int m = 0; m < 4; ++m) { const int ro = ai * 128 + m * 16; const size_t off = (size_t)(orow0 + ro) * DM + col0;
                    const f32x4 x0 = xr0[m], x1 = xr1[m];
                    const f32x4 y0 = x0 + g0 * acc[ai][bj][m][0], y1 = x1 + g1 * acc[ai][bj][m][1];
                    { u32x4 w1; w1.x = pk2(y0[0], y0[1]); w1.y = pk2(y0[2], y0[3]); w1.z = pk2(y1[0], y1[1]); w1.w = pk2(y1[2], y1[3]); *(u32x4*)(x1b + off) = w1; }
                    ss[ai][m] += ((y0[0] * y0[0] + y0[1] * y0[1]) + (y0[2] * y0[2] + y0[3] * y0[3])) + ((y1[0] * y1[0] + y1[1] * y1[1]) + (y1[2] * y1[2] + y1[3] * y1[3]));
                    const f32x4 a0 = y0 * s0, a1 = y1 * s1;
                    u32x4 w; w.x = pk2(a0[0], a0[1]); w.y = pk2(a0[2], a0[3]); w.z = pk2(a1[0], a1[1]); w.w = pk2(a1[2], a1[3]);
                    *(u32x4*)(xn + (size_t)(crow0 + ro) * DM + col0) = w; } } }
#pragma unroll
        for (int ai = 0; ai < 2; ++ai)
#pragma unroll
            for (int m = 0; m < 4; ++m) { float v = ss[ai][m]; v += __shfl_xor(v, 16); v += __shfl_xor(v, 32);
                if (fq == 0) __hip_atomic_fetch_add(ssq + orow0 + ai * 128 + m * 16, (unsigned long long)(v * 16777216.f), __ATOMIC_RELAXED, __HIP_MEMORY_SCOPE_AGENT); }
    }
};

struct EpiRes2L {
    static constexpr bool PERM = true, AFTER_DRAIN = false;
    const bf16_t* x1b; bf16_t* x2b; const LAS float* gT; unsigned long long* ssq;
    __device__ __forceinline__ void operator()(const f32x4 (&acc)[2][2][4][2], const pg8::Unit& u, int wr, int wc, int fr_, int fq_) const {
        int fr = fr_, fq = fq_; asm volatile("" : "+v"(fr), "+v"(fq));
        const int b = u.pm / 17; const int orow0 = (u.pm - b) * 256 + wr * 64 + fr;
        float ss[2][4];
#pragma unroll
        for (int ai = 0; ai < 2; ++ai)
#pragma unroll
            for (int m = 0; m < 4; ++m) ss[ai][m] = 0.f;
#pragma unroll
        for (int bj = 0; bj < 2; ++bj) {
            const int col0 = u.pn * 256 + bj * 128 + wc * 32 + 8 * fq;
            const int ti = (((u.pm - b) >> 6) & 1) * 256 + bj * 128 + wc * 32 + 8 * fq; const f32x4 g0 = *(const LAS f32x4*)(gT + ti), g1 = *(const LAS f32x4*)(gT + ti + 4);
            u32x4 xr[2][4];
#pragma unroll
            for (int ai = 0; ai < 2; ++ai)
#pragma unroll
                for (int m = 0; m < 4; ++m) xr[ai][m] = __builtin_nontemporal_load((const u32x4*)(x1b + (size_t)(orow0 + ai * 128 + m * 16) * DM + col0));
#pragma unroll
            for (int ai = 0; ai < 2; ++ai)
#pragma unroll
                for (int m = 0; m < 4; ++m) { const size_t off = (size_t)(orow0 + ai * 128 + m * 16) * DM + col0;
                    const u32x4 xw = xr[ai][m];
                    const f32x4 x0 = {bflo(xw.x), bfhi(xw.x), bflo(xw.y), bfhi(xw.y)}, x1 = {bflo(xw.z), bfhi(xw.z), bflo(xw.w), bfhi(xw.w)};
                    const f32x4 y0 = x0 + g0 * acc[ai][bj][m][0], y1 = x1 + g1 * acc[ai][bj][m][1];
                    ss[ai][m] += ((y0[0] * y0[0] + y0[1] * y0[1]) + (y0[2] * y0[2] + y0[3] * y0[3])) + ((y1[0] * y1[0] + y1[1] * y1[1]) + (y1[2] * y1[2] + y1[3] * y1[3]));
                    u32x4 w; w.x = pk2(y0[0], y0[1]); w.y = pk2(y0[2], y0[3]); w.z = pk2(y1[0], y1[1]); w.w = pk2(y1[2], y1[3]);
                    *(u32x4*)(x2b + off) = w; } }
#pragma unroll
        for (int ai = 0; ai < 2; ++ai)
#pragma unroll
            for (int m = 0; m < 4; ++m) { float v = ss[ai][m]; v += __shfl_xor(v, 16); v += __shfl_xor(v, 32);
                if (fq == 0) __hip_atomic_fetch_add(ssq + orow0 + ai * 128 + m * 16, (unsigned long long)(v * 16777216.f), __ATOMIC_RELAXED, __HIP_MEMORY_SCOPE_AGENT); }
    }
};

namespace att {
using s16x4 = __attribute__((ext_vector_type(4))) short;
using f32x16 = __attribute__((ext_vector_type(16))) float;
constexpr int NW = 8, QBLK = 32, KVBLK = 64, LDQ = 768, LDK = 1024  , LDKR = 32  , LDV = 1024, LDO = 1024;
constexpr float SCALE = 0.10206207261596575f;
constexpr float THRL = 8.f;
constexpr float C2 = SCALE * 1.4426950408889634f;
constexpr int SHM_K = 12 * 1024, SHM_V = 64 * 64 * 2;
constexpr int OFF_V = 0, OFF_K = 3 * SHM_V, OFF_WS = OFF_K + 3 * SHM_K, OFF_OST = OFF_WS + NW * 64 * 4, ATT_LDS = OFF_OST + NW * 4096;
#define KSWZ(row, colB) ((row) * 256 + ((colB) ^ (((row) & 7) << 4)))
#define SBAR() __builtin_amdgcn_sched_barrier(0)
__device__ __forceinline__ int crow(int r, int hi) { return (r & 3) + 8 * (r >> 2) + 4 * hi; }
__device__ __forceinline__ unsigned cvtpk(float lo, float hi) { unsigned r; asm volatile("v_cvt_pk_bf16_f32 %0, %1, %2" : "=v"(r) : "v"(lo), "v"(hi)); return r; }
__device__ __forceinline__ float rowmax32(const f32x16& p0, const f32x16& p1) {
  float pmax = p0[0];
#pragma unroll
  for (int r = 1; r < 16; ++r) pmax = fmaxf(pmax, p0[r]);
#pragma unroll
  for (int r = 0; r < 16; ++r) pmax = fmaxf(pmax, p1[r]);
  auto rr = __builtin_amdgcn_permlane32_swap(__float_as_uint(pmax), __float_as_uint(pmax), false, false);
  return fmaxf(__uint_as_float(rr[0]), __uint_as_float(rr[1]));
}
__device__ __forceinline__ void move_ref(f32x16& p0, f32x16& p1, float dl, float& m_hat, f32x16& negm) {
  m_hat += dl;
#pragma unroll
  for (int r = 0; r < 16; ++r) { p0[r] -= dl; p1[r] -= dl; }
#pragma unroll
  for (int r = 0; r < 16; ++r) negm[r] = -m_hat;
}
__device__ __forceinline__ void exp16(f32x16& p) {
#pragma unroll
  for (int r = 0; r < 16; ++r) p[r] = __builtin_amdgcn_exp2f(p[r]);
}
__device__ __forceinline__ void finishSM(f32x16& p0, f32x16& p1, float alpha, float& l_reg, bf16x8& pa0, bf16x8& pa1, bf16x8& pa2, bf16x8& pa3) {
#pragma unroll
  for (int r = 0; r < 16; ++r) p1[r] = __builtin_amdgcn_exp2f(p1[r]);
  float ps = 0;
#pragma unroll
  for (int r = 0; r < 16; ++r) ps += p0[r];
#pragma unroll
  for (int r = 0; r < 16; ++r) ps += p1[r];
  { auto rr = __builtin_amdgcn_permlane32_swap(__float_as_uint(ps), __float_as_uint(ps), false, false);
    ps = __uint_as_float(rr[0]) + __uint_as_float(rr[1]); }
  l_reg = l_reg * alpha + ps;
#define PK4(P, BASE, OUT) do { u32x4 w = {cvtpk(P[BASE + 0], P[BASE + 1]), cvtpk(P[BASE + 2], P[BASE + 3]), cvtpk(P[BASE + 4], P[BASE + 5]), cvtpk(P[BASE + 6], P[BASE + 7])}; \
    OUT = *reinterpret_cast<bf16x8*>(&w); } while (0)
  PK4(p0, 0, pa0); PK4(p0, 8, pa1); PK4(p1, 0, pa2); PK4(p1, 8, pa3);
#undef PK4
}
__device__ __forceinline__ void kload(bf16x8* kf, const char* Ks, int r32, int hi) {
  const char* kb = Ks + hi * 1024 + r32 * 16;
#pragma unroll
  for (int d0 = 0; d0 < 6; ++d0) { kf[2 * d0] = *reinterpret_cast<const bf16x8*>(kb + d0 * 2048); kf[2 * d0 + 1] = *reinterpret_cast<const bf16x8*>(kb + d0 * 2048 + 512); }
}
__device__ __forceinline__ void qkt(f32x16& p0, f32x16& p1, const bf16x8* kf, const bf16x8* qr, const f32x16& negm) {
  p0 = negm; p1 = negm;
#pragma unroll
  for (int d0 = 0; d0 < 6; ++d0) {
    p0 = __builtin_amdgcn_mfma_f32_32x32x16_bf16(kf[2 * d0], qr[d0], p0, 0, 0, 0);
    p1 = __builtin_amdgcn_mfma_f32_32x32x16_bf16(kf[2 * d0 + 1], qr[d0], p1, 0, 0, 0); }
}
__device__ __forceinline__ int v_st(int k, int c) { const int kk = k; return ((kk >> 3) * 2 + (c >> 5)) * 512 + ((kk & 7) * 32 + (c & 31)) * 2; }
__device__ __forceinline__ int v_rd_base(int lane) { return ((lane & 3) << 3) | (((lane >> 2) & 3) << 6) | (((lane >> 4) & 1) << 5) | (((lane >> 5) & 1) << 8); }
constexpr int v_rd_off(int d0, int ks, int half) { return d0 * 512 + ks * 2048 + half * 1024; }
template <int OFF> __device__ __forceinline__ s16x4 tr_read(int vb) {
  s16x4 r; asm volatile("ds_read_b64_tr_b16 %0, %1 offset:%2" : "=&v"(r) : "v"(vb), "i"(OFF) : "memory"); return r;
}
typedef __attribute__((address_space(3))) const char* lds_cptr;
typedef short v4i16_t __attribute__((ext_vector_type(4)));
__device__ __forceinline__ s16x4 vtr(lds_cptr p) { return __builtin_bit_cast(s16x4, __builtin_amdgcn_ds_read_tr16_b64_v4i16((__attribute__((address_space(3))) v4i16_t*)p)); }
__device__ __forceinline__ void pv_softmax(f32x16* o, lds_cptr vp, bf16x8 pa0, bf16x8 pa1, bf16x8 pa2, bf16x8 pa3, f32x16& c0, f32x16& c1, float& m_hat, f32x16& negm, float& alpha) {
  s16x4 vl[8], vh[8];
#pragma unroll
  for (int d0 = 0; d0 < 2; ++d0)
#pragma unroll
    for (int ks = 0; ks < 4; ++ks) { vl[d0 * 4 + ks] = vtr(vp + v_rd_off(d0, ks, 0)); vh[d0 * 4 + ks] = vtr(vp + v_rd_off(d0, ks, 1)); }
  const float rm = rowmax32(c0, c1);
#define PKV(i) (bf16x8){vl[i][0], vl[i][1], vl[i][2], vl[i][3], vh[i][0], vh[i][1], vh[i][2], vh[i][3]}
  o[0] = __builtin_amdgcn_mfma_f32_32x32x16_bf16(pa0, PKV(0), o[0], 0, 0, 0);
  o[1] = __builtin_amdgcn_mfma_f32_32x32x16_bf16(pa0, PKV(4), o[1], 0, 0, 0);
  o[0] = __builtin_amdgcn_mfma_f32_32x32x16_bf16(pa1, PKV(1), o[0], 0, 0, 0);
  o[1] = __builtin_amdgcn_mfma_f32_32x32x16_bf16(pa1, PKV(5), o[1], 0, 0, 0);
  o[0] = __builtin_amdgcn_mfma_f32_32x32x16_bf16(pa2, PKV(2), o[0], 0, 0, 0);
  o[1] = __builtin_amdgcn_mfma_f32_32x32x16_bf16(pa2, PKV(6), o[1], 0, 0, 0);
  o[0] = __builtin_amdgcn_mfma_f32_32x32x16_bf16(pa3, PKV(3), o[0], 0, 0, 0);
  o[1] = __builtin_amdgcn_mfma_f32_32x32x16_bf16(pa3, PKV(7), o[1], 0, 0, 0);
#undef PKV
  alpha = 1.f;
  if (__builtin_expect(__any(rm > THRL), 0)) { const float dl = fmaxf(rm, 0.f); move_ref(c0, c1, dl, m_hat, negm); alpha = __builtin_amdgcn_exp2f(-dl); }
  exp16(c0);
  asm volatile("" : "+v"(c0));
}
__device__ __forceinline__ void pv_only(f32x16* o, lds_cptr vp, bf16x8 pa0, bf16x8 pa1, bf16x8 pa2, bf16x8 pa3) {
#pragma unroll
  for (int d0 = 0; d0 < 2; ++d0) { s16x4 l[4], h[4];
#pragma unroll
    for (int ks = 0; ks < 4; ++ks) { l[ks] = vtr(vp + v_rd_off(d0, ks, 0)); h[ks] = vtr(vp + v_rd_off(d0, ks, 1)); }
#define PKV(i) (bf16x8){l[i][0], l[i][1], l[i][2], l[i][3], h[i][0], h[i][1], h[i][2], h[i][3]}
    o[d0] = __builtin_amdgcn_mfma_f32_32x32x16_bf16(pa0, PKV(0), o[d0], 0, 0, 0); o[d0] = __builtin_amdgcn_mfma_f32_32x32x16_bf16(pa1, PKV(1), o[d0], 0, 0, 0);
    o[d0] = __builtin_amdgcn_mfma_f32_32x32x16_bf16(pa2, PKV(2), o[d0], 0, 0, 0); o[d0] = __builtin_amdgcn_mfma_f32_32x32x16_bf16(pa3, PKV(3), o[d0], 0, 0, 0);
#undef PKV
  }
}
template <int D0> __device__ __forceinline__ void pv_one(f32x16& od, int vb, bf16x8 pa0, bf16x8 pa1, bf16x8 pa2, bf16x8 pa3) {
  const s16x4 l0 = tr_read<v_rd_off(D0, 0, 0)>(vb), h0 = tr_read<v_rd_off(D0, 0, 1)>(vb), l1 = tr_read<v_rd_off(D0, 1, 0)>(vb), h1 = tr_read<v_rd_off(D0, 1, 1)>(vb);
  const s16x4 l2 = tr_read<v_rd_off(D0, 2, 0)>(vb), h2 = tr_read<v_rd_off(D0, 2, 1)>(vb), l3 = tr_read<v_rd_off(D0, 3, 0)>(vb), h3 = tr_read<v_rd_off(D0, 3, 1)>(vb);
  asm volatile("s_waitcnt lgkmcnt(0)" ::: "memory"); SBAR();
#define PK(L, H) (bf16x8){L[0], L[1], L[2], L[3], H[0], H[1], H[2], H[3]}
  od = __builtin_amdgcn_mfma_f32_32x32x16_bf16(pa0, PK(l0, h0), od, 0, 0, 0);
  od = __builtin_amdgcn_mfma_f32_32x32x16_bf16(pa1, PK(l1, h1), od, 0, 0, 0);
  od = __builtin_amdgcn_mfma_f32_32x32x16_bf16(pa2, PK(l2, h2), od, 0, 0, 0);
  od = __builtin_amdgcn_mfma_f32_32x32x16_bf16(pa3, PK(l3, h3), od, 0, 0, 0);
#undef PK
}
__device__ __forceinline__ void pv_d0(f32x16* o, int vb, bf16x8 pa0, bf16x8 pa1, bf16x8 pa2, bf16x8 pa3) {
  pv_one<0>(o[0], vb, pa0, pa1, pa2, pa3); pv_one<1>(o[1], vb, pa0, pa1, pa2, pa3);
}
struct AttnRegs { bf16x8 qr[6]; struct { bf16x8 ks0, ks1, vs0; } sr_[2]; bf16x8 k2a, k2b; };
__device__ __forceinline__ void attn_unit(const bf16_t* __restrict__ Qb, const bf16_t* __restrict__ Kh, const bf16_t* __restrict__ Krp, const bf16_t* __restrict__ Vh, bf16_t* __restrict__ Ob, int seq, char* lds, const float* __restrict__ tab, int t0,
                                          AttnRegs& R, bool pre, bool has_next, const bf16_t* __restrict__ Qn, const bf16_t* __restrict__ Khn, const bf16_t* __restrict__ Krn, const bf16_t* __restrict__ Vhn) {
  int tid_ = threadIdx.x; asm volatile("" : "+v"(tid_));
  const int tid = tid_, wid = tid >> 6, lane = tid & 63, r32 = lane & 31, hi = lane >> 5;
  char* V_lds = lds + OFF_V; char* K_lds = lds + OFF_K;
  float* ws = (float*)(lds + OFF_WS) + wid * 64; float* li_l = ws; float* al_l = ws + 32;
  float m_hat = 0.f, l_reg = 0; f32x16 o[2] = {}; bf16x8 (&qr)[6] = R.qr; f32x16 negm = f32x16{};
  if (!pre) { const long qoff = (long)(wid * QBLK + r32) * LDQ + hi * 8;
#pragma unroll
    for (int d0 = 0; d0 < 6; ++d0) qr[d0] = *reinterpret_cast<const bf16x8*>(Qb + qoff + d0 * 16); }
  { const int t = t0 + wid * QBLK + r32;
#pragma unroll
    for (int ax = 0; ax < 2; ++ax) { const int pos = ax == 0 ? (t >> 6) : (t & 63); const float* tp = tab + (pos * 8 + 4 * hi) * 2;
      const f32x4 cs0 = *(const f32x4*)tp, cs1 = *(const f32x4*)(tp + 4); const float c[4] = {cs0[0], cs0[2], cs1[0], cs1[2]}, sn[4] = {cs0[1], cs0[3], cs1[1], cs1[3]};
      const bf16x8 q = qr[4 + ax]; float o1[4], o2[4];
#pragma unroll
      for (int j = 0; j < 4; ++j) { const float x1 = bf2f((unsigned short)q[j]), x2 = bf2f((unsigned short)q[4 + j]); o1[j] = x1 * c[j] - x2 * sn[j]; o2[j] = x2 * c[j] + x1 * sn[j]; }
      u32x4 w = {cvtpk(o1[0], o1[1]), cvtpk(o1[2], o1[3]), cvtpk(o2[0], o2[1]), cvtpk(o2[2], o2[3])}; qr[4 + ax] = *reinterpret_cast<bf16x8*>(&w); } }
  const bool has2 = tid < 256; const int id2 = has2 ? tid + 512 : tid;
  const int k0r = (tid & 7) + 8 * (tid / 96), k0c = (tid >> 3) % 12, k1r = (id2 & 7) + 8 * (id2 / 96), k1c = (id2 >> 3) % 12;
  const int vr = tid >> 3, vc = (tid & 7) * 8, vst0 = v_st(vr, vc);
  const int kst0 = k0c * 1024 + k0r * 16, kst1 = k1c * 1024 + k1r * 16;
  const bf16_t* k0p = k0c < 8 ? Kh + (long)k0r * LDK + k0c * 8 : Krp + (long)k0r * LDKR + (k0c - 8) * 8; const int k0s = (k0c < 8 ? LDK : LDKR) * KVBLK;
  const bf16_t* k1p = k1c < 8 ? Kh + (long)k1r * LDK + k1c * 8 : Krp + (long)k1r * LDKR + (k1c - 8) * 8; const int k1s = (k1c < 8 ? LDK : LDKR) * KVBLK;
  const lds_cptr vp0 = (lds_cptr)V_lds + v_rd_base(lane);
  auto& sr_ = R.sr_;
#define SLOADP(i, tk, tv, K0P, K1P, VH) do { sr_[i].vs0 = *reinterpret_cast<const bf16x8*>(&(VH)[(long)((tv) * KVBLK + vr) * LDV + vc]); \
    sr_[i].ks0 = *reinterpret_cast<const bf16x8*>((K0P) + (long)(tk) * k0s); sr_[i].ks1 = *reinterpret_cast<const bf16x8*>((K1P) + (long)(tk) * k1s); } while (0)
#define SLOAD(i, tk, tv) SLOADP(i, tk, tv, k0p, k1p, Vh)
#define SWRITEK(b, i) do { *(bf16x8*)(K_lds + (b) * SHM_K + kst0) = sr_[i].ks0; if (has2) *(bf16x8*)(K_lds + (b) * SHM_K + kst1) = sr_[i].ks1; } while (0)
#define SWRITEV(b, i) do { *(bf16x8*)(V_lds + (b) * SHM_V + vst0) = sr_[i].vs0; } while (0)
#define SWAIT() asm volatile("s_waitcnt vmcnt(3)" ::: "memory")
#define RESC(a) do { if (__any((a) < 1.f)) { if (hi == 0) al_l[r32] = (a); asm volatile("s_waitcnt lgkmcnt(0)" ::: "memory"); \
    _Pragma("unroll") for (int d = 0; d < 2; ++d) _Pragma("unroll") for (int r = 0; r < 16; ++r) o[d][r] *= al_l[crow(r, hi)]; } } while (0)
  f32x16 pA0, pA1, pB0, pB1; float alA, alB; bf16x8 pa0, pa1, pa2, pa3; const int NT = seq / KVBLK;
  constexpr int SE = 0, SO = 1;
  bf16x8 kf[12];
  int s0 = 0, s1 = 1, s2 = 2;
#define ROT() do { const int o_ = s0; s0 = s1; s1 = s2; s2 = o_; } while (0)
#define STEP(C0, C1, alC, P0, P1, alP, SP, t) do { \
    SBAR(); qkt(C0, C1, kf, qr, negm); \
    finishSM(P0, P1, alP, l_reg, pa0, pa1, pa2, pa3); SBAR(); \
    SWAIT(); if ((t) + 2 < NT) SWRITEK(s0, SP); if ((t) < NT) SWRITEV(s1, SP);                  \
    if ((t) + 4 < NT) SLOAD(SP, (t) + 4, (t) + 2); else if ((t) + 2 < NT) SLOAD(SP, (t) + 2, (t) + 2); SBAR(); \
    pv_softmax(o, vp0 + s0 * SHM_V, pa0, pa1, pa2, pa3, C0, C1, m_hat, negm, alC); \
    if ((t) + 1 < NT) kload(kf, K_lds + s2 * SHM_K, r32, hi); SBAR(); \
    RESC(alC); __syncthreads(); ROT(); } while (0)
  __syncthreads();
  if (!pre) { SLOAD(SE, 0, 0); SLOAD(SO, 1, 1); R.k2a = *reinterpret_cast<const bf16x8*>(k0p + 2L * k0s); R.k2b = *reinterpret_cast<const bf16x8*>(k1p + 2L * k1s); }
  asm volatile("s_waitcnt vmcnt(0)" ::: "memory");
  SWRITEK(0, SE); SWRITEV(0, SE); SWRITEK(1, SO);
  *(bf16x8*)(K_lds + 2 * SHM_K + kst0) = R.k2a; if (has2) *(bf16x8*)(K_lds + 2 * SHM_K + kst1) = R.k2b;
  SLOAD(SO, 3, 1); SLOAD(SE, 4, 2); __syncthreads();
  kload(kf, K_lds, r32, hi); qkt(pA0, pA1, kf, qr, negm); kload(kf, K_lds + SHM_K, r32, hi);
  { const float rm = rowmax32(pA0, pA1); move_ref(pA0, pA1, rm, m_hat, negm); alA = 1.f; exp16(pA0); }
  __syncthreads();
  int t = 1;
  for (; t + 1 < NT; t += 2) {
    STEP(pB0, pB1, alB, pA0, pA1, alA, SO, t);
    STEP(pA0, pA1, alA, pB0, pB1, alB, SE, t + 1);
  }
  STEP(pB0, pB1, alB, pA0, pA1, alA, SO, t);
  finishSM(pB0, pB1, alB, l_reg, pa0, pa1, pa2, pa3); SBAR();
  if (has_next) {
    int t2 = threadIdx.x; asm volatile("" : "+v"(t2));
    const int w2 = t2 >> 6, l2 = t2 & 63; const long qoff = (long)(w2 * QBLK + (l2 & 31)) * LDQ + (l2 >> 5) * 8;
#pragma unroll
    for (int d0 = 0; d0 < 6; ++d0) qr[d0] = *reinterpret_cast<const bf16x8*>(Qn + qoff + d0 * 16);
    const int j2 = t2 < 256 ? t2 + 512 : t2; const int a0r = (t2 & 7) + 8 * (t2 / 96), a0c = (t2 >> 3) % 12, a1r = (j2 & 7) + 8 * (j2 / 96), a1c = (j2 >> 3) % 12, bvr = t2 >> 3, bvc = (t2 & 7) * 8;
    const bf16_t* k0n = a0c < 8 ? Khn + (long)a0r * LDK + a0c * 8 : Krn + (long)a0r * LDKR + (a0c - 8) * 8; const int s0n = (a0c < 8 ? LDK : LDKR) * KVBLK;
    const bf16_t* k1n = a1c < 8 ? Khn + (long)a1r * LDK + a1c * 8 : Krn + (long)a1r * LDKR + (a1c - 8) * 8; const int s1n = (a1c < 8 ? LDK : LDKR) * KVBLK;
    sr_[SE].vs0 = *reinterpret_cast<const bf16x8*>(&Vhn[(long)bvr * LDV + bvc]); sr_[SE].ks0 = *reinterpret_cast<const bf16x8*>(k0n); sr_[SE].ks1 = *reinterpret_cast<const bf16x8*>(k1n);
    sr_[SO].vs0 = *reinterpret_cast<const bf16x8*>(&Vhn[(long)(KVBLK + bvr) * LDV + bvc]); sr_[SO].ks0 = *reinterpret_cast<const bf16x8*>(k0n + s0n); sr_[SO].ks1 = *reinterpret_cast<const bf16x8*>(k1n + s1n);
    R.k2a = *reinterpret_cast<const bf16x8*>(k0n + 2L * s0n); R.k2b = *reinterpret_cast<const bf16x8*>(k1n + 2L * s1n); }
  else { R.k2a = bf16x8{}; R.k2b = bf16x8{}; }
  SBAR();
  pv_only(o, vp0 + s0 * SHM_V, pa0, pa1, pa2, pa3);
#undef STEP
#undef ROT
#undef SWRITEK
#undef SWRITEV
  if (hi == 0) li_l[r32] = l_reg; asm volatile("s_waitcnt lgkmcnt(0)" ::: "memory");
  float rli[16];
#pragma unroll
  for (int r = 0; r < 16; ++r) rli[r] = __builtin_amdgcn_rcpf(li_l[crow(r, hi)]);
  { bf16_t* stg = (bf16_t*)(lds + OFF_OST) + wid * 2048;
#pragma unroll
    for (int r = 0; r < 16; ++r) { const int orow = crow(r, hi);
#pragma unroll
      for (int d0 = 0; d0 < 2; ++d0) stg[orow * 64 + d0 * 32 + r32] = (bf16_t)(cvtpk(o[d0][r] * rli[r], 0.f) & 0xffffu); }
    asm volatile("s_waitcnt lgkmcnt(0)" ::: "memory");
    bf16_t* Ow = Ob + (long)(wid * QBLK) * LDO;
#pragma unroll
    for (int i = 0; i < 4; ++i) { const int row = i * 8 + (lane >> 3), ch = lane & 7; const u32x4 v = *(const u32x4*)(stg + row * 64 + ch * 8); *(u32x4*)(Ow + (long)row * LDO + ch * 8) = v; } }
#undef SLOAD
#undef SLOADP
#undef SWRITE
#undef SWAIT
#undef RESC
}
#undef SBAR
}

__device__ __forceinline__ int qperm16(int w) { return w < 4 ? w : (w < 8 ? w + 4 : (w < 12 ? w - 4 : w)); }
__device__ __forceinline__ void transpose_item(const float* W, int K, int N, bf16_t* WT, LAS float* scr, int item, int lane, int mode  ) {
    const int nblk = N / 32, kb = item / nblk, nb = item % nblk, k0 = 64 * kb; int n0 = 32 * nb;
    int s0 = n0;
    if (mode == 3) {
        if (nb >= 45) { const int e = nb - 45; n0 = 1024 + 256 * (e >> 2) + 128 + 32 * (e & 3); }
        else if (nb >= 29) { const int e = nb - 29; n0 = 1024 + 256 * (e >> 2) + 32 * (e & 3); }
    }
    if (mode == 2) s0 = (n0 < 512) ? (n0 >> 6) * 128 + (n0 & 63) : ((n0 - 512) >> 6) * 128 + 64 + ((n0 - 512) & 63);
    { f32x4 wv[8]; const int kr = lane >> 3, c4 = (lane & 7) * 4;
#pragma unroll
      for (int i = 0; i < 8; ++i) wv[i] = __builtin_nontemporal_load((const f32x4*)(W + (size_t)(k0 + 8 * i + kr) * N + s0 + c4));
#pragma unroll
      for (int i = 0; i < 8; ++i) { LAS float* d = scr + (8 * i + kr) * 33 + c4; d[0] = wv[i][0]; d[1] = wv[i][1]; d[2] = wv[i][2]; d[3] = wv[i][3]; } }
    asm volatile("s_waitcnt lgkmcnt(0)" ::: "memory");
    const int c = lane & 7;
#pragma unroll
    for (int j = 0; j < 4; ++j) { const int n = (lane >> 3) + 8 * j; int ns = n;
        if (mode == 1) { const int col = n0 + n, d = col % 96; if (d >= 64) ns = (n & 16) | qperm16(n & 15); }
        const LAS float* s = scr + (8 * c) * 33 + ns;
        u32x4 o; o.x = pk2(s[0 * 33], s[1 * 33]); o.y = pk2(s[2 * 33], s[3 * 33]); o.z = pk2(s[4 * 33], s[5 * 33]); o.w = pk2(s[6 * 33], s[7 * 33]);
        *(u32x4*)(WT + (size_t)(n0 + n) * K + k0 + 8 * c) = o; }
    asm volatile("s_waitcnt lgkmcnt(0)" ::: "memory");
}
__device__ __forceinline__ void adaln_item(const float* c, const float* cctx, const float* wmod, const float* bmod, float* MOD, int item, LAS float* sm) {
    const int tid = threadIdx.x;
    for (int i = tid; i < 9 * 1024; i += 512) { const float v = (i < 8192) ? c[i] : cctx[i - 8192]; sm[i] = v / (1.f + expf(-v)); }
    __syncthreads();
    const int col = tid & 31, kg = tid >> 5, n = item * 32 + col;
    float acc[9];
#pragma unroll
    for (int r = 0; r < 9; ++r) acc[r] = 0.f;
#pragma unroll 32
    for (int kk = 0; kk < 64; ++kk) { const int k = kg * 64 + kk; const float w = __builtin_nontemporal_load(wmod + (size_t)k * NMOD + n);
#pragma unroll
        for (int r = 0; r < 9; ++r) acc[r] += sm[r * 1024 + k] * w; }
    LAS float* red = sm + 9 * 1024;
#pragma unroll
    for (int r = 0; r < 9; ++r) red[(kg * 9 + r) * 32 + col] = acc[r];
    __syncthreads();
    if (tid < 288) { const int r = tid >> 5, cc = tid & 31; float s = 0.f;
#pragma unroll
        for (int g2 = 0; g2 < 16; ++g2) s += red[(g2 * 9 + r) * 32 + cc];
        MOD[r * NMOD + item * 32 + cc] = s + bmod[item * 32 + cc]; }
    __syncthreads();
}

#define XB_TMO      128
#define XB_XCNT(j)  (256  + 64 * (j))
#define XB_XSUB(j)  (1280 + 64 * (j))
#define XB_XGEN(j)  (2304 + 64 * (j))
#define XB_TOP      3328
#define XB_TOPGEN   3392
#define XCD_BAR_WORDS 3456
#define ADALN_CNT_WORD 3584
#define XB_SPIN_CAP (1u << 18)

__device__ __forceinline__ unsigned xb_ld(unsigned* p)              { return __hip_atomic_load(p, __ATOMIC_RELAXED, __HIP_MEMORY_SCOPE_AGENT); }
__device__ __forceinline__ unsigned xb_add(unsigned* p, unsigned v) { return __hip_atomic_fetch_add(p, v, __ATOMIC_RELAXED, __HIP_MEMORY_SCOPE_AGENT); }
__device__ __forceinline__ unsigned xb_xcc_id() { return (unsigned)__builtin_amdgcn_s_getreg((3 << 11) | 20) & 0xFu; }
#define XB_SPIN(cond, bar) do { unsigned _sp = 0; while (cond) { __builtin_amdgcn_s_sleep(1); \
    if ((++_sp & 255u) == 0u) { if (xb_ld(&(bar)[XB_TMO])) break; if (_sp > XB_SPIN_CAP) { atomicAdd(&(bar)[XB_TMO], 1u); break; } } } } while (0)

struct XcdBarrier {
    unsigned* bar; unsigned x;
    volatile LAS unsigned* st;
};

__device__ __forceinline__ XcdBarrier xcd_barrier_post(unsigned* bar, volatile LAS unsigned* st) {
    XcdBarrier b; b.bar = bar; b.x = xb_xcc_id(); b.st = st;
    if (threadIdx.x == 0) (void)xb_add(&bar[XB_XCNT(b.x)], 1u);
    return b;
}
__device__ __forceinline__ void xcd_barrier_complete(unsigned* bar, unsigned x, unsigned& nloc, unsigned& nx) {
    const unsigned G = gridDim.x * gridDim.y * gridDim.z;
    unsigned sum, cnt, mine, sp = 0u;
    for (;;) {
        sum = 0u; cnt = 0u; mine = 0u;
#pragma unroll
        for (unsigned j = 0; j < 16; ++j) { const unsigned c = xb_ld(&bar[XB_XCNT(j)]); sum += c; cnt += (c > 0u) ? 1u : 0u; mine = (j == x) ? c : mine; }
        if (sum == G) break;
        __builtin_amdgcn_s_sleep(1);
        if ((++sp & 255u) == 0u) { if (xb_ld(&bar[XB_TMO])) break; if (sp > XB_SPIN_CAP) { atomicAdd(&bar[XB_TMO], 1u); break; } }
    }
    nloc = mine > 0u ? mine : 1u; nx = cnt > 0u ? cnt : 1u;
}

__device__ __forceinline__ void xcd_barrier(const XcdBarrier& b) {
    asm volatile("s_waitcnt vmcnt(0)" ::: "memory");
    __syncthreads();
    if (threadIdx.x == 0) {
        unsigned* bar = b.bar;
        __builtin_amdgcn_s_waitcnt(0);
        unsigned nloc = b.st[0], nx = b.st[1];
        if (nloc == 0u) { xcd_barrier_complete(bar, b.x, nloc, nx); b.st[0] = nloc; b.st[1] = nx; }
        const unsigned old = xb_add(&bar[XB_XSUB(b.x)], 1u);
        const unsigned gen = old / nloc;
        if (old + 1u == (gen + 1u) * nloc) {
            __builtin_amdgcn_fence(__ATOMIC_RELEASE, "agent");
            asm volatile("s_waitcnt vmcnt(0)" ::: "memory");
            const unsigned og = xb_add(&bar[XB_TOP], 1u);
            const unsigned tg = og / nx;
            if (og + 1u == (tg + 1u) * nx) xb_add(&bar[XB_TOPGEN], 1u);
            else XB_SPIN(xb_ld(&bar[XB_TOPGEN]) == tg, bar);
            __builtin_amdgcn_fence(__ATOMIC_ACQUIRE, "agent");
            xb_add(&bar[XB_XGEN(b.x)], 1u);
            asm volatile("s_waitcnt vmcnt(0)" ::: "memory");
        } else {
            XB_SPIN(xb_ld(&bar[XB_XGEN(b.x)]) == gen, bar);
            __builtin_amdgcn_fence(__ATOMIC_ACQUIRE, "agent");
            asm volatile("s_waitcnt vmcnt(0)" ::: "memory");
        }
    }
    __syncthreads();
}

struct Args { const float* in[16]; float* out; unsigned char* ws; };

__global__ void __launch_bounds__(512, 2) fwd_megakernel(Args a) {
    extern __shared__ __attribute__((aligned(16))) unsigned char lds[];
    cg::grid_group grid = cg::this_grid();
    const int G = gridDim.x, bx = blockIdx.x;
    const int vcu = (G % 8 == 0) ? (bx % 8) * (G / 8) + bx / 8 : bx;
    const int NGW = G * 8;
#define PHASE_IDS int tid_ = threadIdx.x; asm volatile("" : "+v"(tid_)); const int tid = tid_, lane = tid & 63, wave = __builtin_amdgcn_readfirstlane(tid >> 6), gw = vcu * 8 + wave; (void)tid; (void)lane; (void)gw;
    LAS unsigned char* ldsl = (LAS unsigned char*)lds;
    unsigned* barw = (unsigned*)(a.ws + WS_BAR);
    volatile LAS unsigned* MISC = (volatile LAS unsigned*)(ldsl + 131072);
    if (threadIdx.x < 4) MISC[threadIdx.x] = 0u;
    __syncthreads();
    if (a.ws == nullptr) grid.sync();
    const XcdBarrier xbar = xcd_barrier_post(barw, MISC);
    const float* x = a.in[0]; const float* cvec = a.in[1]; const float* ctx = a.in[2]; const float* cctx = a.in[3]; const float* w_mod = a.in[4]; const float* b_mod = a.in[5];
    const float* w_in = a.in[6]; const float* q_g = a.in[7]; const float* w_uq = a.in[8]; const float* kv_g = a.in[9]; const float* w_ukv = a.in[10]; const float* conv_w = a.in[11];
    const float* w_out = a.in[12]; const float* w_mlp1 = a.in[13]; const float* w_mlp2 = a.in[14]; const float* fin_g = a.in[15];
    float* out = a.out; unsigned char* ws = a.ws;
    float* MOD = (float*)(ws + WS_MOD); float* TAB = (float*)(ws + WS_TAB);
    unsigned long long* SSQ = (unsigned long long*)(ws + WS_SSQ); float* BIAS2 = (float*)(ws + WS_B2);
    unsigned long long* SSQ2 = (unsigned long long*)(ws + WS_SSQ2); bf16_t* X1b = (bf16_t*)out  ; bf16_t* X2b = (bf16_t*)(ws + WS_XN)  ;
    bf16_t* Win_t = (bf16_t*)(ws + WS_WIN); bf16_t* Wuq_t = (bf16_t*)(ws + WS_WUQ); bf16_t* Wkv_t = (bf16_t*)(ws + WS_WKV); bf16_t* Wo_t = (bf16_t*)(ws + WS_WO);
    bf16_t* W1_t = (bf16_t*)(ws + WS_W1); bf16_t* W2_t = (bf16_t*)(ws + WS_W2);
    bf16_t* XN = (bf16_t*)(ws + WS_XN); bf16_t* AC = (bf16_t*)(ws + WS_AC); bf16_t* Vb = (bf16_t*)(ws + WS_V); bf16_t* Z = (bf16_t*)(ws + WS_Z);
    bf16_t* CQ = (bf16_t*)(ws + WS_CQ); bf16_t* CKV = (bf16_t*)(ws + WS_CKV); bf16_t* Qb = (bf16_t*)(ws + WS_Q); bf16_t* KV2 = (bf16_t*)(ws + WS_KV); bf16_t* KR = (bf16_t*)(ws + WS_KR); bf16_t* Hb = (bf16_t*)(ws + WS_H);

#ifndef PHMASK
#define PHMASK 0xFFFF
#endif
#define PH(n) if ((PHMASK >> (n)) & 1)
    PH(0) {
    PHASE_IDS
    { unsigned ndone = 0u;
      for (int it = vcu; it < NMOD / 32; it += G) { adaln_item(cvec, cctx, w_mod, b_mod, MOD, it, (LAS float*)ldsl); ++ndone; }
      if (ndone) {
          asm volatile("s_waitcnt vmcnt(0)" ::: "memory"); __syncthreads();
          if (tid == 0) { __builtin_amdgcn_fence(__ATOMIC_RELEASE, "agent"); asm volatile("s_waitcnt vmcnt(0)" ::: "memory"); __hip_atomic_fetch_add(barw + ADALN_CNT_WORD, ndone, __ATOMIC_RELAXED, __HIP_MEMORY_SCOPE_AGENT); } } }
    if (vcu == G - 1) { const int pos = tid >> 3, i = tid & 7; const float fr = powf(10000.f, -(float)(2 * i) / 16.f); const float ang = (float)pos * fr; TAB[tid * 2] = cosf(ang); TAB[tid * 2 + 1] = sinf(ang); }
    {
        LAS float* scr = (LAS float*)(ldsl + wave * 16384);
        constexpr int I_IN = (DM / 64) * (INC / 32), I_UQ = (QLR / 64) * (768 / 32), I_KV = (KVLR / 64) * (1024 / 32), I_O = (DM / 64) * (DM / 32), I_1 = (DM / 64) * (DFF / 32), I_2 = (DFF / 64) * (DM / 32);
        constexpr int NIT = I_IN + I_UQ + I_KV + I_O + I_1 + I_2;
        for (int it = gw; it < NIT; it += NGW) {
            int r = it;
            if (r < I_1) { transpose_item(w_mlp1, DM, DFF, W1_t, scr, r, lane, 0); continue; } r -= I_1;
            if (r < I_2) { transpose_item(w_mlp2, DFF, DM, W2_t, scr, r, lane, 0); continue; } r -= I_2;
            if (r < I_IN) { transpose_item(w_in, DM, INC, Win_t, scr, r, lane, 3); continue; } r -= I_IN;
            if (r < I_O) { transpose_item(w_out, DM, DM, Wo_t, scr, r, lane, 0); continue; } r -= I_O;
            if (r < I_UQ) { transpose_item(w_uq, QLR, 768, Wuq_t, scr, r, lane, 1); continue; } r -= I_UQ;
            transpose_item(w_ukv, KVLR, 1024, Wkv_t, scr, r, lane, 2);
        }
        for (int i = gw * 64 + lane; i < (ZP - INC) * DM / 8; i += NGW * 64) *(u32x4*)(Win_t + (size_t)928 * DM + (size_t)i * 8) = (u32x4){0u, 0u, 0u, 0u};
    }
    }
    { if (threadIdx.x == 0) { unsigned sp = 0u; while (__hip_atomic_load(barw + ADALN_CNT_WORD, __ATOMIC_RELAXED, __HIP_MEMORY_SCOPE_AGENT) < (unsigned)(NMOD / 32)) { __builtin_amdgcn_s_sleep(2); if (++sp > (1u << 22)) break; }
        __builtin_amdgcn_fence(__ATOMIC_ACQUIRE, "agent"); asm volatile("s_waitcnt vmcnt(0)" ::: "memory"); }
      __syncthreads(); }

    PH(1) { PHASE_IDS
    for (int r0 = gw; r0 < MROWS; r0 += 2 * NGW) {
        const float* src[2]; const float* md[2]; bool ok[2]; f32x4 v[2][4]; float s[2];
#pragma unroll
        for (int q = 0; q < 2; ++q) { const int r = r0 + q * NGW; ok[q] = r < MROWS; const int rr = ok[q] ? r : r0; const int b = rr / TOK, t = rr - b * TOK;
            src[q] = t < SEQ ? x + ((size_t)b * SEQ + t) * DM : ctx + ((size_t)b * CTX + (t - SEQ)) * DM; md[q] = MOD + (t < SEQ ? b : 8) * NMOD; }
#pragma unroll
        for (int q = 0; q < 2; ++q)
#pragma unroll
            for (int j = 0; j < 4; ++j) v[q][j] = __builtin_nontemporal_load((const f32x4*)src[q] + lane + 64 * j);
#pragma unroll
        for (int q = 0; q < 2; ++q) { s[q] = 0.f;
#pragma unroll
            for (int j = 0; j < 4; ++j) s[q] += (v[q][j].x * v[q][j].x + v[q][j].y * v[q][j].y) + (v[q][j].z * v[q][j].z + v[q][j].w * v[q][j].w); }
#pragma unroll
        for (int q = 0; q < 2; ++q) if (ok[q]) { const int r = r0 + q * NGW; const float rstd = rsqrtf(wave_sum(s[q]) * (1.f / DM) + EPS);
#pragma unroll
            for (int j = 0; j < 4; ++j) { const f32x4 sh = ((const f32x4*)md[q])[lane + 64 * j], sc = ((const f32x4*)(md[q] + DM))[lane + 64 * j]; const f32x4 y = v[q][j] * rstd * (sc + 1.f) + sh;
                u32x2 w; w.x = pk2(y.x, y.y); w.y = pk2(y.z, y.w); *(u32x2*)(XN + (size_t)r * DM + 4 * (lane + 64 * j)) = w; } }
    }
    for (int i = gw * 64 + lane; i < NB * SEQ; i += NGW * 64) { SSQ[i] = 0ull; SSQ2[i] = 0ull; }
    }
    xcd_barrier(xbar);

    PH(2) {
        pg8::Gemm g{XN, Win_t, MROWS, ZP, DM}; Sched S{8, 1024, 1024, G, vcu, 1};
        EpiZ E{Z};
        pg8::gemm_phase<EpiZ, Sched, true, true>(ldsl, g, S, E);
    }
    xcd_barrier(xbar);

    PH(3) {
        constexpr int NC = 8; const bool ctxwg = vcu >= G - NC; const int ctxrow0 = ((vcu - (G - NC)) * 17 + 16) * 256;
        if (ctxwg) {
            pg8::Gemm g{XN, Win_t, MROWS, ZP, DM}; SchedOne S1{(vcu - (G - NC)) * 17 + 16, 1};
            EpiZ E{Z};
            pg8::gemm_phase<EpiZ, SchedOne, true, true>(ldsl, g, S1, E);
            asm volatile("s_waitcnt vmcnt(0)" ::: "memory"); __syncthreads(); __builtin_amdgcn_fence(__ATOMIC_ACQUIRE, "agent");
        }
        PHASE_IDS
        {
    for (int n = vcu * 8 + wave; n < DFF; n += 2 * NGW) {
        const int n2 = (n + NGW < DFF) ? n + NGW : n;
        const u32x4 w0 = *(const u32x4*)(W1_t + (size_t)n * DM + 16 * lane), w1 = *(const u32x4*)(W1_t + (size_t)n * DM + 16 * lane + 8);
        const u32x4 y0 = *(const u32x4*)(W1_t + (size_t)n2 * DM + 16 * lane), y1 = *(const u32x4*)(W1_t + (size_t)n2 * DM + 16 * lane + 8);
        float wv[16], yv[16];
#pragma unroll
        for (int q = 0; q < 4; ++q) { wv[2 * q] = bflo(w0[q]); wv[2 * q + 1] = bfhi(w0[q]); wv[8 + 2 * q] = bflo(w1[q]); wv[8 + 2 * q + 1] = bfhi(w1[q]);
                                      yv[2 * q] = bflo(y0[q]); yv[2 * q + 1] = bfhi(y0[q]); yv[8 + 2 * q] = bflo(y1[q]); yv[8 + 2 * q + 1] = bfhi(y1[q]); }
        f32x4 sv[NB][4];
#pragma unroll
        for (int b = 0; b < NB; ++b)
#pragma unroll
            for (int q = 0; q < 4; ++q) sv[b][q] = *(const f32x4*)(MOD + b * NMOD + 3 * DM + 16 * lane + 4 * q);
#pragma unroll
        for (int b = 0; b < NB; ++b) { float a1 = 0.f, a2 = 0.f;
#pragma unroll
            for (int q = 0; q < 4; ++q) { const f32x4 v = sv[b][q];
                a1 += (v[0] * wv[4 * q] + v[1] * wv[4 * q + 1]) + (v[2] * wv[4 * q + 2] + v[3] * wv[4 * q + 3]);
                a2 += (v[0] * yv[4 * q] + v[1] * yv[4 * q + 1]) + (v[2] * yv[4 * q + 2] + v[3] * yv[4 * q + 3]); }
            a1 = wave_sum(a1); a2 = wave_sum(a2); if (lane == 0) { BIAS2[b * DFF + n] = a1; BIAS2[b * DFF + n2] = a2; } }
    }
        }
        const int ch0 = 8 * lane;
        float cw[3][8];
#pragma unroll
        for (int k = 0; k < 3; ++k)
#pragma unroll
            for (int j = 0; j < 8; ++j) cw[k][j] = conv_w[k * 512 + ch0 + j];
        if (!ctxwg)
        for (int pi = gw; pi < NB * SEQ / 2; pi += (G - NC) * 8) {
            const int b = pi >> 11, t = (pi & 2047) * 2; const int r = b * TOK + t; const bf16_t* z = Z + (size_t)r * ZW;
            const int p = lane & 15, ax = p >> 3, i = p & 7;
            typedef float f32x2_t __attribute__((ext_vector_type(2)));
            unsigned wk[2]; u32x2 wq[2]; bf16_t k1[2], k2[2]; u32x4 gb[2], uu[4]; f32x2_t cs2[2];
#pragma unroll
            for (int q = 0; q < 2; ++q) { const bf16_t* zq = z + q * ZW; wk[q] = *(const unsigned*)(zq + 256 + 2 * lane); wq[q] = *(const u32x2*)(zq + 4 * lane);
                k1[q] = zq[384 + ax * 16 + i]; k2[q] = zq[384 + ax * 16 + 8 + i]; gb[q] = __builtin_nontemporal_load((const u32x4*)(zq + 416 + ch0));
                uu[1 + q] = *(const u32x4*)(zq + 928 + ch0);
                { const int tq = t + q, pos = ax == 0 ? (tq >> 6) : (tq & 63); cs2[q] = *(const f32x2_t*)(TAB + (pos * 8 + i) * 2); } }
            uu[0] = (u32x4){0u, 0u, 0u, 0u}; uu[3] = uu[0];
            if (t > 0) uu[0] = *(const u32x4*)(z - ZW + 928 + ch0);
            if (t + 2 < SEQ) uu[3] = *(const u32x4*)(z + 2 * ZW + 928 + ch0);
            const float kg0 = kv_g[2 * lane], kg1 = kv_g[2 * lane + 1]; const f32x4 qg = *(const f32x4*)(q_g + 4 * lane);
            float skv[2], sq[2];
#pragma unroll
            for (int q = 0; q < 2; ++q) { const float v0 = bflo(wk[q]), v1 = bfhi(wk[q]); skv[q] = v0 * v0 + v1 * v1;
                const float a0 = bflo(wq[q].x), a1 = bfhi(wq[q].x), a2 = bflo(wq[q].y), a3 = bfhi(wq[q].y); sq[q] = (a0 * a0 + a1 * a1) + (a2 * a2 + a3 * a3); }
#pragma unroll
            for (int q = 0; q < 2; ++q) { skv[q] = wave_sum(skv[q]); sq[q] = wave_sum(sq[q]); }
#pragma unroll
            for (int q = 0; q < 2; ++q) { const int rq = r + q, tq = t + q;
                { const float rstd = rsqrtf(skv[q] * (1.f / KVLR) + EPS); *(unsigned*)(CKV + (size_t)rq * KVLR + 2 * lane) = pk2(bflo(wk[q]) * rstd * kg0, bfhi(wk[q]) * rstd * kg1); }
                { const float rstd = rsqrtf(sq[q] * (1.f / QLR) + EPS); u32x2 o; o.x = pk2(bflo(wq[q].x) * rstd * qg.x, bfhi(wq[q].x) * rstd * qg.y); o.y = pk2(bflo(wq[q].y) * rstd * qg.z, bfhi(wq[q].y) * rstd * qg.w);
                  *(u32x2*)(CQ + (size_t)rq * QLR + 4 * lane) = o; }
                { const float cs = cs2[q].x, sn = cs2[q].y; const float x1 = bf2f(k1[q]), x2 = bf2f(k2[q]);
                  const float o1 = x1 * cs - x2 * sn, o2 = x2 * cs + x1 * sn; const int w1 = i < 4 ? i : i + 4, w2 = i < 4 ? 4 + i : 8 + i;
                  if (lane < 16) { bf16_t* kp = KR + (size_t)rq * 32 + ax * 16; kp[w1] = (bf16_t)(pk2(o1, 0.f) & 0xffffu); kp[w2] = (bf16_t)(pk2(o2, 0.f) & 0xffffu); } }
                u32x4 o;
#pragma unroll
                for (int c = 0; c < 4; ++c) {
                    const float ylo = bflo(gb[q][c]) * (cw[0][2 * c] * bflo(uu[q][c]) + cw[1][2 * c] * bflo(uu[q + 1][c]) + cw[2][2 * c] * bflo(uu[q + 2][c]));
                    const float yhi = bfhi(gb[q][c]) * (cw[0][2 * c + 1] * bfhi(uu[q][c]) + cw[1][2 * c + 1] * bfhi(uu[q + 1][c]) + cw[2][2 * c + 1] * bfhi(uu[q + 2][c]));
                    o[c] = pk2(ylo, yhi); }
                *(u32x4*)(AC + (size_t)rq * DM + 512 + ch0) = o; }
        }
    }
    xcd_barrier(xbar);

    {
        constexpr int NC4 = 8; const bool ctxwg = vcu >= G - NC4; const int ctile = (vcu - (G - NC4)) * 17 + 16, ctxrow0 = ctile * 256; const int GL = G - NC4;
        if (ctxwg) {
            { PHASE_IDS
            for (int it = wave; it < 64; it += 8) {
                const int r = ctxrow0 + it * 4 + (lane >> 4), p = lane & 15; const bf16_t* z = Z + (size_t)r * ZW;
                const u32x4 w = *(const u32x4*)(z + 256 + 8 * p); float v[8];
#pragma unroll
                for (int q = 0; q < 4; ++q) { v[2 * q] = bflo(w[q]); v[2 * q + 1] = bfhi(w[q]); }
                float ss = 0.f;
#pragma unroll
                for (int q = 0; q < 8; ++q) ss += v[q] * v[q];
                ss += __shfl_xor(ss, 1); ss += __shfl_xor(ss, 2); ss += __shfl_xor(ss, 4); ss += __shfl_xor(ss, 8);
                const float rstd = rsqrtf(ss * (1.f / KVLR) + EPS); const f32x4 g0 = *(const f32x4*)(kv_g + 8 * p), g1 = *(const f32x4*)(kv_g + 8 * p + 4);
                u32x4 o; o.x = pk2(v[0] * rstd * g0[0], v[1] * rstd * g0[1]); o.y = pk2(v[2] * rstd * g0[2], v[3] * rstd * g0[3]); o.z = pk2(v[4] * rstd * g1[0], v[5] * rstd * g1[1]); o.w = pk2(v[6] * rstd * g1[2], v[7] * rstd * g1[3]);
                *(u32x4*)(CKV + (size_t)r * KVLR + 8 * p) = o;
                const int ax = p >> 3, i = p & 7; const bf16_t k1 = z[384 + ax * 16 + i], k2 = z[384 + ax * 16 + 8 + i]; const int w1 = i < 4 ? i : i + 4, w2 = i < 4 ? 4 + i : 8 + i;
                { bf16_t* kp = KR + (size_t)r * 32 + ax * 16; kp[w1] = k1; kp[w2] = k2; }
            }
            }
            asm volatile("s_waitcnt vmcnt(0)" ::: "memory"); __syncthreads(); __builtin_amdgcn_fence(__ATOMIC_ACQUIRE, "agent");
        } else {
            pg8::Gemm g{CQ, Wuq_t, MROWS, 768, QLR}; Sched S{3, 384, 384, GL, vcu, 1};
            EpiStore<2> E{Qb, 768, att::C2};
            pg8::gemm_phase<EpiStore<2>, Sched, true, true>(ldsl, g, S, E);
        }
        {
            pg8::Gemm g{CKV, Wkv_t, MROWS, 1024, KVLR};
            const Sched S = ctxwg ? Sched{4, ctile * 4 + 4, ctile * 4 + 4, 1, ctile * 4, 0} : Sched{4, 512, 512, GL, (vcu + 100) % GL, 1};
            EpiStore<0> E{KV2, 1024, 1.f};
            pg8::gemm_phase<EpiStore<0>, Sched, true, true>(ldsl, g, S, E);
        }
    }
    xcd_barrier(xbar);

    PH(6) {
        const int xcd = vcu / (G / 8), slot = vcu % (G / 8);
        att::AttnRegs R; bool pre = false;
        float* tabL = (float*)((char*)lds + 102400);
        { const int t_ = threadIdx.x; *(u32x2*)(tabL + 2 * t_) = *(const u32x2*)(TAB + 2 * t_); }
        __syncthreads();
        const int nun = (G == 256) ? 4 : (1024 - vcu + G - 1) / G;
        for (int i = 0; i < nun; ++i) {
            int bh, qb, bhn, qbn;
            if (G == 256) { bh = i * 16 + xcd * 2 + (slot >> 4); qb = slot & 15; bhn = bh + 16; qbn = qb; }
            else { const int U = i * G + vcu; bh = U >> 4; qb = U & 15; const int Un = U + G; bhn = Un >> 4; qbn = Un & 15; }
            const int b = bh >> 3, h = bh & 7, bn = bhn >> 3, hn = bhn & 7;
            const size_t row0 = (size_t)b * TOK, row0n = (size_t)bn * TOK;
            const bool has_next = (i + 1 < nun);
            att::attn_unit(Qb + (row0 + qb * 256) * 768 + h * 96, KV2 + row0 * 1024 + h * 64, KR + row0 * 32, KV2 + row0 * 1024 + 512 + h * 64, AC + (row0 + qb * 256) * DM + h * 64, TOK, (char*)lds, tabL, qb * 256,
                           R, pre, has_next, Qb + (row0n + qbn * 256) * 768 + hn * 96, KV2 + row0n * 1024 + hn * 64, KR + row0n * 32, KV2 + row0n * 1024 + 512 + hn * 64);
            pre = has_next;
        }
    }
    xcd_barrier(xbar);

    PH(7) {
        pg8::Gemm g{AC, Wo_t, MROWS, DM, DM}; Sched S{4, 512, 512, G, vcu, 1};
        if (G == 256) {
            LAS float* gT = (LAS float*)(ldsl + 131072 + 1024); LAS float* sT = gT + 512;
            { const int t_ = threadIdx.x; const float* mb = MOD + ((vcu >> 6) + 4 * (t_ >> 8)) * NMOD + (vcu & 3) * 256 + (t_ & 255); gT[t_] = mb[2 * DM]; sT[t_] = mb[4 * DM] + 1.f; }
            __syncthreads();
            EpiRes1L EL{x, X1b, gT, sT, XN, SSQ};
            pg8::gemm_phase<EpiRes1L, Sched, true, true>(ldsl, g, S, EL);
        } else {
        EpiRes1 E{x, X1b, MOD, XN, SSQ};
        pg8::gemm_phase<EpiRes1, Sched, true, true>(ldsl, g, S, E); }
    }
    xcd_barrier(xbar);

    PH(9) {
        pg8::Gemm g{XN, W1_t, MROWS, DFF, DM}; EpiMlp1 E{Hb, SSQ, BIAS2};
        if (G == 256) {
            LAS float* rsT = (LAS float*)(ldsl + 131072 + 1024); LAS float* bsT = rsT + 512;
            { const int t_ = threadIdx.x, x_ = vcu >> 5, s_ = vcu & 31;
              const int lrow = (16 * x_ + 8 * (t_ >> 8) + (s_ & 7)) * 256 + (t_ & 255);
              rsT[t_] = rsqrtf((float)SSQ[lrow] * (1.f / (16777216.f * DM)) + EPS);
#pragma unroll
              for (int c = 0; c < 2; ++c) { const int e = t_ + 512 * c, ct = e >> 8; bsT[e] = BIAS2[x_ * DFF + (4 * ct + (s_ >> 3)) * 256 + (e & 255)]; } }
            __syncthreads();
            EpiMlp1L EL{Hb, rsT, bsT};
            SchedUp S{vcu}; pg8::gemm_phase<EpiMlp1L, SchedUp, true, true>(ldsl, g, S, EL); }
        else { Sched S{16, 2048, 2048, G, vcu, 1}; pg8::gemm_phase<EpiMlp1, Sched, true, true>(ldsl, g, S, E); }
    }
    xcd_barrier(xbar);

    PH(10) {
        pg8::Gemm g{Hb, W2_t, MROWS, DM, DFF}; Sched S{4, 512, 512, G, vcu, 1};
        if (G == 256) {
            LAS float* gT = (LAS float*)(ldsl + 131072 + 1024);
            { const int t_ = threadIdx.x; gT[t_] = MOD[((vcu >> 6) + 4 * (t_ >> 8)) * NMOD + 5 * DM + (vcu & 3) * 256 + (t_ & 255)]; }
            __syncthreads();
            EpiRes2L EL{X1b, X2b, gT, SSQ2};
            pg8::gemm_phase<EpiRes2L, Sched, true, true>(ldsl, g, S, EL);
        } else {
        EpiRes2 E{X1b, X2b, MOD + 5 * DM, SSQ2};
        pg8::gemm_phase<EpiRes2, Sched, true, true>(ldsl, g, S, E); }
    }
    xcd_barrier(xbar);

    PH(11) { PHASE_IDS
    for (int r0 = gw; r0 < NB * SEQ; r0 += 2 * NGW) {
        u32x4 w[2][2]; float rs[2]; bool ok[2];
#pragma unroll
        for (int q = 0; q < 2; ++q) { const int r = r0 + q * NGW; ok[q] = r < NB * SEQ; const int rr = ok[q] ? r : r0; const bf16_t* p = X2b + (size_t)rr * DM;
            w[q][0] = __builtin_nontemporal_load((const u32x4*)(p + 8 * lane)); w[q][1] = __builtin_nontemporal_load((const u32x4*)(p + 512 + 8 * lane)); rs[q] = rsqrtf((float)SSQ2[rr] * (1.f / (16777216.f * DM)) + EPS); }
#pragma unroll
        for (int q = 0; q < 2; ++q) if (ok[q]) { float* p = out + (size_t)(r0 + q * NGW) * DM;
#pragma unroll
            for (int hf = 0; hf < 2; ++hf) { const int c = hf * 512 + 8 * lane; const f32x4 g0 = *(const f32x4*)(fin_g + c), g1 = *(const f32x4*)(fin_g + c + 4); const u32x4 v = w[q][hf];
                const f32x4 a = {bflo(v.x), bfhi(v.x), bflo(v.y), bfhi(v.y)}, bq = {bflo(v.z), bfhi(v.z), bflo(v.w), bfhi(v.w)};
                __builtin_nontemporal_store(a * rs[q] * g0, (f32x4*)(p + c)); __builtin_nontemporal_store(bq * rs[q] * g1, (f32x4*)(p + c + 4)); } }
    } }
}

constexpr int LDS_BYTES = 147456;

extern "C" void kernel_launch(void* const* d_in, const int* in_sizes, int n_in, void* d_out, int out_size, void* d_ws, size_t ws_size, hipStream_t stream) {
    static int grid = 0;
    if (grid == 0) {
        if (n_in != 16 || in_sizes[0] != NB * SEQ * DM || out_size != NB * SEQ * DM || ws_size < WS_END) {
            fprintf(stderr, "kernel_launch: unexpected shapes / workspace (n_in %d, ws %zu, need %zu)\n", n_in, ws_size, (size_t)WS_END); grid = -1; return; }
        int dev = 0, cus = 0, per_cu = 0;
        if (hipGetDevice(&dev) != hipSuccess || hipDeviceGetAttribute(&cus, hipDeviceAttributeMultiprocessorCount, dev) != hipSuccess) { grid = -1; return; }
        if (hipFuncSetAttribute((const void*)fwd_megakernel, hipFuncAttributeMaxDynamicSharedMemorySize, LDS_BYTES) != hipSuccess) { fprintf(stderr, "kernel_launch: hipFuncSetAttribute failed\n"); grid = -1; return; }
        if (hipOccupancyMaxActiveBlocksPerMultiprocessor(&per_cu, (const void*)fwd_megakernel, 512, LDS_BYTES) != hipSuccess || per_cu < 1) { fprintf(stderr, "kernel_launch: occupancy query says %d\n", per_cu); per_cu = 1; }
        (void)hipGetLastError();
        grid = cus;
    }
    if (grid < 0) return;
    Args a{};
    for (int i = 0; i < 16; ++i) a.in[i] = (const float*)d_in[i];
    a.out = (float*)d_out; a.ws = (unsigned char*)d_ws;
    void* args[] = {&a};
    if (hipMemsetAsync((char*)d_ws + WS_BAR, 0, 16384, stream) != hipSuccess) { fprintf(stderr, "kernel_launch: hipMemsetAsync of the barrier words failed\n"); return; }
    hipError_t e = hipLaunchCooperativeKernel((const void*)fwd_megakernel, dim3(grid), dim3(512), args, LDS_BYTES, stream);
    if (e != hipSuccess) fprintf(stderr, "cooperative launch failed: %s (grid %d)\n", hipGetErrorString(e), grid);
}
```
